# Optimizing an MI355X kernel written in HIP

```python
import math
import jax, jax.numpy as jnp
from jax import lax
import numpy as np

D_MODEL = 1024
BATCH = 8
SEQ = 4096
DEPTH = 1

EPS = 1e-6
BLOCK_Q = 128
PLE_DIM = 256
MLA_HEADS = 8
MLA_NOPE = 64
MLA_ROPE = 32
MLA_V = 64
MLA_Q_RANK = 384
MLA_KV_RANK = 256
ROPE_THETA = 10000.0
MLA_SCALE = 1.0 / math.sqrt(MLA_NOPE + MLA_ROPE)
SB_HEADS = 8
SB_DIM = 64
SB_SCALE = 1.0 / math.sqrt(SB_DIM)
D_FF = ((8 * D_MODEL // 3 + 255) // 256) * 256
IN_WIDTHS = (MLA_Q_RANK, MLA_KV_RANK, MLA_ROPE,
             SB_HEADS * SB_DIM, SB_HEADS * SB_DIM, SB_HEADS * SB_DIM,
             D_MODEL, D_MODEL)
D_IN = sum(IN_WIDTHS)
NEG_INF = -1e30

kernel_name = "hybrid_mla_stickbreaking_gated_block"


def rms_norm(x, g):
    x32 = x.astype(jnp.float32)
    y = x32 * lax.rsqrt(jnp.mean(x32 * x32, axis=-1, keepdims=True) + EPS)
    return (y * g.astype(jnp.float32)).astype(x.dtype)


def split_cols(t, widths):
    outs, start = [], 0
    for w in widths:
        outs.append(t[..., start:start + w])
        start += w
    return outs


def rope_tables(positions, dtype):
    inv_freq = 1.0 / (ROPE_THETA ** (jnp.arange(0, MLA_ROPE, 2, dtype=jnp.float32) / MLA_ROPE))
    ang = positions.astype(jnp.float32)[..., None] * inv_freq
    return jnp.cos(ang).astype(dtype), jnp.sin(ang).astype(dtype)


def apply_rope(t, cos, sin):
    half = t.shape[-1] // 2
    t1, t2 = t[..., :half], t[..., half:]
    return jnp.concatenate([t1 * cos - t2 * sin, t1 * sin + t2 * cos], axis=-1)


def to_blocks(t):
    B, S, H, d = t.shape
    return t.reshape(B, S // BLOCK_Q, BLOCK_Q, H, d).transpose(1, 0, 3, 2, 4)


def from_blocks(o):
    nb, B, H, Q, d = o.shape
    return o.transpose(1, 0, 3, 2, 4).reshape(B, nb * Q, H * d)


def mla_attention(q_nope, q_pe, k_nope, k_pe, v):
    S = q_nope.shape[1]
    nb = S // BLOCK_Q
    qn, qp = to_blocks(q_nope), to_blocks(q_pe)
    kn = k_nope.transpose(0, 2, 1, 3)
    vv = v.transpose(0, 2, 1, 3)
    kpos = jnp.arange(S)

    def step(args):
        qn_b, qp_b, blk = args
        qpos = blk * BLOCK_Q + jnp.arange(BLOCK_Q)
        s = (jnp.einsum('bhqd,bhkd->bhqk', qn_b, kn)
             + jnp.einsum('bhqr,bkr->bhqk', qp_b, k_pe)).astype(jnp.float32) * MLA_SCALE
        s = jnp.where(kpos[None, :] <= qpos[:, None], s, NEG_INF)
        w = jax.nn.softmax(s, axis=-1).astype(vv.dtype)
        return jnp.einsum('bhqk,bhkd->bhqd', w, vv)

    return from_blocks(lax.map(step, (qn, qp, jnp.arange(nb))))


def stick_breaking_attention(q, k, v):
    S = q.shape[1]
    nb = S // BLOCK_Q
    qb = to_blocks(q)
    kk = k.transpose(0, 2, 1, 3)
    vv = v.transpose(0, 2, 1, 3)
    kpos = jnp.arange(S)

    def step(args):
        q_b, blk = args
        qpos = blk * BLOCK_Q + jnp.arange(BLOCK_Q)
        causal = kpos[None, :] < qpos[:, None]
        z = jnp.einsum('bhqd,bhkd->bhqk', q_b, kk).astype(jnp.float32) * SB_SCALE
        log_1m = jnp.where(causal, jax.nn.log_sigmoid(-z), 0.0)
        after = lax.cumsum(log_1m, axis=3, reverse=True) - log_1m
        a = jnp.where(causal, jnp.exp(jax.nn.log_sigmoid(z) + after), 0.0)
        return jnp.einsum('bhqk,bhkd->bhqd', a.astype(vv.dtype), vv)

    return from_blocks(lax.map(step, (qb, jnp.arange(nb))))


def setup_inputs(seed: int = 0) -> dict:
    key = jax.random.key(seed)
    ks = jax.random.split(key, 24)
    f32 = jnp.float32

    def w(k, shape):
        return jax.random.normal(k, shape, f32) * (shape[-2] ** -0.5)

    def gain(k, shape):
        return 1.0 + 0.01 * jax.random.normal(k, shape, f32)

    L = DEPTH
    return {
        "x": jax.random.normal(ks[0], (BATCH, SEQ, D_MODEL), f32),
        "p": jax.random.normal(ks[1], (DEPTH, BATCH, SEQ, PLE_DIM), f32),
        "positions": jnp.broadcast_to(jnp.arange(SEQ, dtype=jnp.int32), (BATCH, SEQ)),
        "g_mix": gain(ks[2], (L, D_MODEL)),
        "w_in": w(ks[3], (L, D_MODEL, D_IN)),
        "g_q_a": gain(ks[4], (L, MLA_Q_RANK)),
        "w_q_b": w(ks[5], (L, MLA_Q_RANK, MLA_HEADS * (MLA_NOPE + MLA_ROPE))),
        "g_kv_a": gain(ks[6], (L, MLA_KV_RANK)),
        "w_kv_b": w(ks[7], (L, MLA_KV_RANK, MLA_HEADS * (MLA_NOPE + MLA_V))),
        "w_br_mla": w(ks[8], (L, MLA_HEADS * MLA_V, D_MODEL)),
        "w_br_sb": w(ks[9], (L, SB_HEADS * SB_DIM, D_MODEL)),
        "w_out": w(ks[10], (L, D_MODEL, D_MODEL)),
        "g_ffn": gain(ks[11], (L, D_MODEL)),
        "w_ffn_gate": w(ks[12], (L, D_MODEL, D_FF)),
        "w_ffn_up": w(ks[13], (L, D_MODEL, D_FF)),
        "w_ffn_down": w(ks[14], (L, D_FF, D_MODEL)),
        "w_ple_gate": w(ks[15], (L, D_MODEL, D_MODEL)),
        "w_ple_proj": w(ks[16], (L, PLE_DIM, D_MODEL)),
        "g_ple": gain(ks[17], (L, D_MODEL)),
        "g_final": gain(ks[18], (D_MODEL,)),
    }


def reference(x, p, positions, g_mix, w_in, g_q_a, w_q_b, g_kv_a, w_kv_b, w_br_mla, w_br_sb,
              w_out, g_ffn, w_ffn_gate, w_ffn_up, w_ffn_down, w_ple_gate, w_ple_proj, g_ple,
              g_final):
    B, S, _ = x.shape
    cos, sin = rope_tables(positions, x.dtype)
    h = x
    for i in range(DEPTH):
        n = rms_norm(h, g_mix[i])
        proj = n @ w_in[i]
        c_q, c_kv, k_pe, q_sb, k_sb, v_sb, gate_a, gate_b = split_cols(proj, IN_WIDTHS)

        q = (rms_norm(c_q, g_q_a[i]) @ w_q_b[i]).reshape(B, S, MLA_HEADS, MLA_NOPE + MLA_ROPE)
        q_nope, q_pe = q[..., :MLA_NOPE], q[..., MLA_NOPE:]
        q_pe = apply_rope(q_pe, cos[:, :, None, :], sin[:, :, None, :])
        kv = (rms_norm(c_kv, g_kv_a[i]) @ w_kv_b[i]).reshape(B, S, MLA_HEADS, MLA_NOPE + MLA_V)
        k_nope, v_mla = kv[..., :MLA_NOPE], kv[..., MLA_NOPE:]
        k_pe = apply_rope(k_pe, cos, sin)
        o_a = mla_attention(q_nope, q_pe, k_nope, k_pe, v_mla)

        o_b = stick_breaking_attention(q_sb.reshape(B, S, SB_HEADS, SB_DIM),
                                       k_sb.reshape(B, S, SB_HEADS, SB_DIM),
                                       v_sb.reshape(B, S, SB_HEADS, SB_DIM))

        merged = (jax.nn.sigmoid(gate_a) * (o_a @ w_br_mla[i])
                  + jax.nn.sigmoid(gate_b) * (o_b @ w_br_sb[i]))
        h = h + merged @ w_out[i]

        n2 = rms_norm(h, g_ffn[i])
        h = h + (jax.nn.silu(n2 @ w_ffn_gate[i]) * (n2 @ w_ffn_up[i])) @ w_ffn_down[i]

        e = rms_norm(p[i] @ w_ple_proj[i], g_ple[i])
        h = h + jax.nn.sigmoid(h @ w_ple_gate[i]) * e
    return rms_norm(h, g_final)
```

```cpp
#include <hip/hip_runtime.h>
#include <hip/hip_cooperative_groups.h>
#include <cstdio>
#include <cstdint>
namespace cg = cooperative_groups;

constexpr int NB = 8, SEQ = 4096, DM = 1024, NTOK = NB * SEQ;
constexpr int PLE = 256, QRANK = 384, KVRANK = 256, ROPE = 32, NH = 8;
constexpr int DFF = 2816, DINP = 4352;
constexpr int C_CQ = 0, C_CKV = 384, C_KPE = 640, C_QSB = 768, C_KSB = 1280, C_VSB = 1792, C_GA = 2304, C_GB = 3328;
constexpr float EPS = 1e-6f;
constexpr float LOG2E = 1.4426950408889634f;
constexpr float MLA_C2 = 0.10206207261596575f * 1.4426950408889634f;

namespace pg8 {
#define PG8_LAS __attribute__((address_space(3)))
typedef unsigned short bf16_t;
typedef short bf16x8 __attribute__((ext_vector_type(8)));
typedef float f32x4 __attribute__((ext_vector_type(4)));
typedef unsigned u32x4 __attribute__((ext_vector_type(4)));
constexpr int BM = 256, BK = 64, HALF = 128, HTB = HALF * BK * 2  , STAGE_BYTES = 8 * HTB, NXCD = 8, WGM = 8;

__host__ __device__ __forceinline__ int lds_byte(int r, int c) { const int st = (r >> 4) * 2 + (c >> 5), rr = r & 15, cc = c & 31, ob = rr * 64 + cc * 2; return st * 1024 + (ob ^ (((ob >> 9) & 1) << 5)); }
__host__ __device__ __forceinline__ void stage_rc(int b, int& R, int& C) { const int st = b / 1024, sb = b % 1024, swz = sb ^ (((sb >> 9) & 1) << 5); R = (st >> 1) * 16 + swz / 64; C = (st & 1) * 32 + (swz % 64) / 2; }
__host__ __device__ __forceinline__ int perm32(int rho) { const int n = rho >> 4, i = rho & 15; return 8 * (i >> 2) + 4 * n + (i & 3); }

struct Unit { int pm, pn, kh; };
struct Gemm { const bf16_t* A; const bf16_t* Bt; int M, N, K; int lda; int ldb; };

struct StaticOrder {
    int nM, nN, nwg, G, c;
    __host__ __device__ void init(int M, int N, int G_, int c_) { nM = M / BM; nN = N / BM; nwg = nM * nN; G = G_; c = c_; }
    __host__ __device__ bool next(int i, Unit& u) const {
        const long L = (long)i * G + c; if (L >= nwg) return false;
        int wgid = (int)L; { const int q = nwg / NXCD, r = nwg % NXCD, xcd = wgid % NXCD, off = wgid / NXCD; wgid = (xcd < r ? xcd * (q + 1) : r * (q + 1) + (xcd - r) * q) + off; }
        const int nig = WGM * nN, gid = wgid / nig, fm = gid * WGM, gsz = (nM - fm) < WGM ? (nM - fm) : WGM;
        u.pm = fm + ((wgid % nig) % gsz); u.pn = (wgid % nig) / gsz; return true;
    }
    __device__ __forceinline__ void a_ready(const Unit&) const {}
    __device__ __forceinline__ void done(const Unit&) const {}
};

typedef float f32x2_c __attribute__((ext_vector_type(2))); typedef __bf16 bf16x2_c __attribute__((ext_vector_type(2)));
__device__ __forceinline__ unsigned cvt_pk_bf16(float lo, float hi) { f32x2_c v = {lo, hi}; bf16x2_c b = __builtin_convertvector(v, bf16x2_c); return __builtin_bit_cast(unsigned, b); }
__device__ __forceinline__ float bf_lo(unsigned w) { return __uint_as_float(w << 16); }
__device__ __forceinline__ float bf_hi(unsigned w) { return __uint_as_float(w & 0xffff0000u); }
__device__ __forceinline__ float sigmoidf_fast(float v) { return __builtin_amdgcn_rcpf(1.0f + __builtin_amdgcn_exp2f(-v * 1.4426950408889634f)); }
__device__ __forceinline__ u32x4 pack8(const f32x4& a, const f32x4& b) { u32x4 w; w.x = cvt_pk_bf16(a[0], a[1]); w.y = cvt_pk_bf16(a[2], a[3]); w.z = cvt_pk_bf16(b[0], b[1]); w.w = cvt_pk_bf16(b[2], b[3]); return w; }
__device__ __forceinline__ void unpack8(const u32x4& w, f32x4& a, f32x4& b) { a = (f32x4){bf_lo(w.x), bf_hi(w.x), bf_lo(w.y), bf_hi(w.y)}; b = (f32x4){bf_lo(w.z), bf_hi(w.z), bf_lo(w.w), bf_hi(w.w)}; }

enum EpiMode { M_GATEF = 9, M_SCALER = 8, M_PROJ = 0, M_SCALE = 1, M_SIG = 2, M_GATE1 = 3, M_GATE2 = 4, M_RES = 5, M_RES2 = 6, M_SWIGLU = 7 };
template <int MODE> struct Epi {
    static constexpr bool PERM = true, AFTER_DRAIN = false, HAS_MID = (MODE == M_GATEF);
    __device__ __forceinline__ void mid(f32x4 (&acc)[2][2][4][2], const Unit& u, int wr, int wc, int fr, int fq) const {
        const unsigned lane_off = (unsigned)(((wr * 64 + fr) * ldg + wc * 32 + 8 * fq) * 2);
#pragma unroll
        for (int ai = 0; ai < 2; ++ai)
#pragma unroll
            for (int m = 0; m < 4; ++m) {
#pragma unroll
                for (int bj = 0; bj < 2; ++bj) { const size_t uni = ((size_t)(u.pm * BM + ai * HALF + m * 16) * ldg + 256 * (2 * u.pn + bj)) * 2;
                    f32x4 a, b; unpack8(*(const u32x4*)((const char*)G + uni + lane_off), a, b);
                    acc[ai][bj][m][0] = acc[ai][bj][m][0] * a; acc[ai][bj][m][1] = acc[ai][bj][m][1] * b; }
                asm volatile("" ::: "memory"); }
    }
    bf16_t* O; int ldo;
    const bf16_t* G; int ldg;
    const float* X; float* H;
    float scale;
    float* SQ;
    int np; float inv_n;
    __device__ __forceinline__ void operator()(const f32x4 (&acc)[2][2][4][2], const Unit& u, int wr, int wc, int fr, int fq) const {
        const int row0 = u.pm * BM + wr * 64 + fr;
#pragma unroll
        for (int ai = 0; ai < 2; ++ai)
#pragma unroll
            for (int m = 0; m < 4; ++m) {
                const size_t row = (size_t)(row0 + ai * HALF + m * 16);
                if constexpr (MODE == M_SWIGLU) {
                    const int col = u.pn * HALF + wc * 32 + 8 * fq;
                    f32x4 g0 = acc[ai][0][m][0], g1 = acc[ai][0][m][1]; const f32x4 u0 = acc[ai][1][m][0], u1 = acc[ai][1][m][1];
#pragma unroll
                    for (int i = 0; i < 4; ++i) { g0[i] = g0[i] * sigmoidf_fast(g0[i]) * u0[i]; g1[i] = g1[i] * sigmoidf_fast(g1[i]) * u1[i]; }
                    *(u32x4*)(O + row * ldo + col) = pack8(g0, g1);
                } else {
                    float rsc = scale;
                    if constexpr (MODE == M_SCALER) { float t = 0.f;
#pragma unroll
                        for (int k = 0; k < 3; ++k) if (4 * k < np) { const f32x4 pz = *(const f32x4*)(SQ + row * np + 4 * k); t += (pz[0] + pz[1]) + (pz[2] + pz[3]); }
                        rsc = scale / sqrtf(t * inv_n + 1e-6f); }
#pragma unroll
                    for (int bj = 0; bj < 2; ++bj) {
                        const int col = u.pn * BM + bj * HALF + wc * 32 + 8 * fq;
                        f32x4 v0 = acc[ai][bj][m][0], v1 = acc[ai][bj][m][1];
                        if constexpr (MODE == M_PROJ) {
                            if (u.pn <= 2) { unsigned char* wsb = (unsigned char*)SQ; float* SQq = (float*)(wsb + 37u * 1048576u); float* SKV = (float*)(wsb + 46u * 1048576u);
                                const float* CS = (const float*)(wsb + 40u * 1048576u); const float* SN = (const float*)(wsb + 42u * 1048576u); bf16_t* KP = (bf16_t*)(wsb + 44u * 1048576u);
                                if (!(u.pn == 2 && bj == 1)) {
                                    float q = (v0[0] * v0[0] + v0[1] * v0[1]) + (v0[2] * v0[2] + v0[3] * v0[3]) + (v1[0] * v1[0] + v1[1] * v1[1]) + (v1[2] * v1[2] + v1[3] * v1[3]);
                                    q += __shfl_xor(q, 16); q += __shfl_xor(q, 32);
                                    if (fq == 0) { if (u.pn == 0) SQq[row * 12 + bj * 4 + wc] = q; else if (u.pn == 1 && bj == 0) SQq[row * 12 + 8 + wc] = q; else if (u.pn == 1) SKV[row * 8 + wc] = q; else SKV[row * 8 + 4 + wc] = q; }
                                } else if (wc == 0) {
                                    const int j0 = 8 * (fq & 1); f32x4 r0, r1;
                                    { const f32x4 c = *(const f32x4*)(CS + row * 16 + j0), sn = *(const f32x4*)(SN + row * 16 + j0);
#pragma unroll
                                      for (int i = 0; i < 4; ++i) { const float xp = __shfl_xor(v0[i], 32); r0[i] = fq < 2 ? v0[i] * c[i] - xp * sn[i] : xp * sn[i] + v0[i] * c[i]; } }
                                    { const f32x4 c = *(const f32x4*)(CS + row * 16 + j0 + 4), sn = *(const f32x4*)(SN + row * 16 + j0 + 4);
#pragma unroll
                                      for (int i = 0; i < 4; ++i) { const float xp = __shfl_xor(v1[i], 32); r1[i] = fq < 2 ? v1[i] * c[i] - xp * sn[i] : xp * sn[i] + v1[i] * c[i]; } }
                                    *(u32x4*)(KP + row * 32 + 8 * fq) = pack8(r0, r1);
                                }
                            }
                            if (u.pn >= 9) {
                                if (bj == 0) { f32x4 a0 = acc[ai][0][m][0], a1 = acc[ai][0][m][1], b0 = acc[ai][1][m][0], b1 = acc[ai][1][m][1];
#pragma unroll
                                    for (int i = 0; i < 4; ++i) { const float sb0 = __builtin_fmaxf(sigmoidf_fast(b0[i]), 1e-30f), sb1 = __builtin_fmaxf(sigmoidf_fast(b1[i]), 1e-30f);
                                        a0[i] = sigmoidf_fast(a0[i]) * __builtin_amdgcn_rcpf(sb0); a1[i] = sigmoidf_fast(a1[i]) * __builtin_amdgcn_rcpf(sb1); b0[i] = sb0; b1[i] = sb1; }
                                    *(u32x4*)(O + row * ldo + col) = pack8(a0, a1); *(u32x4*)(O + row * ldo + col + HALF) = pack8(b0, b1); }
                            } else { if (u.pn == 3 || u.pn == 4) { v0 = v0 * 0.125f; v1 = v1 * 0.125f; }
                                *(u32x4*)(O + row * ldo + col) = pack8(v0, v1); }
                        } else if constexpr (MODE == M_GATEF) {
                            const unsigned lane_off = (unsigned)(((wr * 64 + fr) * ldg + wc * 32 + 8 * fq) * 2);
                            const size_t uni = ((size_t)(u.pm * BM + ai * HALF + m * 16) * ldg + 256 * (2 * u.pn + bj) + HALF) * 2;
                            f32x4 a, b; unpack8(*(const u32x4*)((const char*)G + uni + lane_off), a, b);
                            *(u32x4*)(O + row * ldo + col) = pack8(v0 * a, v1 * b);
                        } else if constexpr (MODE == M_SCALER) {
                            v0 = v0 * rsc; v1 = v1 * rsc;
                            *(u32x4*)(O + row * ldo + col) = pack8(v0, v1);
                        } else if constexpr (MODE == M_SCALE) {
                            v0 = v0 * scale; v1 = v1 * scale;
                            *(u32x4*)(O + row * ldo + col) = pack8(v0, v1);
                        } else if constexpr (MODE == M_SIG) {
#pragma unroll
                            for (int i = 0; i < 4; ++i) { v0[i] = sigmoidf_fast(v0[i]); v1[i] = sigmoidf_fast(v1[i]); }
                            *(u32x4*)(O + row * ldo + col) = pack8(v0, v1);
                        } else if constexpr (MODE == M_GATE1) {
                            f32x4 a, b; unpack8(*(const u32x4*)(G + row * ldg + col), a, b);
                            v0 = v0 * a; v1 = v1 * b;
                            *(u32x4*)(O + row * ldo + col) = pack8(v0, v1);
                        } else if constexpr (MODE == M_GATE2) {
                            f32x4 a, b, c, d; unpack8(*(const u32x4*)(G + row * ldg + col), a, b); unpack8(*(const u32x4*)(O + row * ldo + col), c, d);
                            v0 = c + v0 * a; v1 = d + v1 * b;
                            *(u32x4*)(O + row * ldo + col) = pack8(v0, v1);
                        } else if constexpr (MODE == M_RES) {
                            const f32x4 x0 = *(const f32x4*)(X + row * DM + col), x1 = *(const f32x4*)(X + row * DM + col + 4);
                            v0 = x0 + v0; v1 = x1 + v1;
                            *(u32x4*)(O + row * ldo + col) = pack8(v0, v1);
                        } else if constexpr (MODE == M_RES2) {
                            f32x4 x0, x1; unpack8(*(const u32x4*)(G + row * ldg + col), x0, x1);
                            v0 = x0 + v0; v1 = x1 + v1;
                            *(u32x4*)(O + row * ldo + col) = pack8(v0, v1);
                        }
                    }
                }
                if (m & 1) asm volatile("" ::: "memory");
            }
    }
};

struct SplitOrder {
    StaticOrder base;
    __device__ bool next(int i, Unit& u) const { const bool ok = base.next(i >> 1, u); u.kh = i & 1; return ok; }
    __device__ __forceinline__ void a_ready(const Unit&) const {}
    __device__ __forceinline__ void done(const Unit&) const {}
};

template <class Epi, class Sched, bool ALIGN_EPI = false, bool SP2 = false>
__device__ __forceinline__ void gemm_phase(PG8_LAS unsigned char* lds, const Gemm g, const Sched& S, const Epi& E) {
    int tid_ = threadIdx.x; asm volatile("" : "+v"(tid_));
    const int tid = tid_, wid = __builtin_amdgcn_readfirstlane(tid >> 6), lane = tid & 63, wr = wid >> 2, wc = wid & 3, fr = lane & 15, fq = lane >> 4;
    const int K = g.K, nt = K / BK, lda = g.lda ? g.lda : g.K, ldb = g.ldb ? g.ldb : g.K;
    unsigned voffA[2], voffB[2];
#pragma unroll
    for (int i = 0; i < 2; ++i) { int R, C; stage_rc(tid * 16 + i * 8192, R, C); const int Rb = Epi::PERM ? ((R & ~31) + perm32(R & 31)) : R;
        voffA[i] = (unsigned)(R * lda + C) * 2u; voffB[i] = (unsigned)(Rb * ldb + C) * 2u; }
    const size_t kstep = (size_t)(BK * 2);
    const size_t hstep = (size_t)HALF * ldb * 2;
    const size_t tstep = 2 * hstep;
    const size_t hstepA = (size_t)HALF * lda * 2, tstepA = 2 * hstepA;
    const unsigned ldsw = (unsigned)wid * 1024u;
    const int aoff = lds_byte(wr * 64 + fr, fq * 8), boff = lds_byte(wc * 32 + fr, fq * 8);
#define PG8_SA(b, h) (((b) * 2 + (h)) * HTB)
#define PG8_SB(b, h) ((4 + (b) * 2 + (h)) * HTB)
#define PG8_STAGE(bufoff, gbase, voff) do { _Pragma("unroll") for (int _i = 0; _i < 2; ++_i) \
        __builtin_amdgcn_global_load_lds((const unsigned*)((const char*)(gbase) + (voff)[_i]), (PG8_LAS unsigned*)(lds + (bufoff) + ldsw + _i * 8192), 16, 0, 0); } while (0)
#define PG8_LDA(dst, b, h) do { _Pragma("unroll") for (int m = 0; m < 4; ++m) _Pragma("unroll") for (int k = 0; k < 2; ++k) dst[m][k] = *(const PG8_LAS bf16x8*)(lds + PG8_SA(b, h) + aoff + m * 2048 + k * 1024); } while (0)
#define PG8_LDB(dst, b, h) do { _Pragma("unroll") for (int n = 0; n < 2; ++n) _Pragma("unroll") for (int k = 0; k < 2; ++k) dst[n][k] = *(const PG8_LAS bf16x8*)(lds + PG8_SB(b, h) + boff + n * 2048 + k * 1024); } while (0)
#define PG8_MMA(ai, bj, At, Bt) do { __builtin_amdgcn_s_setprio(1); _Pragma("unroll") for (int m = 0; m < 4; ++m) _Pragma("unroll") for (int n = 0; n < 2; ++n) _Pragma("unroll") for (int k = 0; k < 2; ++k) \
        acc[ai][bj][m][n] = __builtin_amdgcn_mfma_f32_16x16x32_bf16(Bt[n][k], At[m][k], acc[ai][bj][m][n], 0, 0, 0); __builtin_amdgcn_s_setprio(0); } while (0)
#define PG8_WAIT_V(n) asm volatile("s_waitcnt vmcnt(" #n ")" ::: "memory")
#define PG8_WAIT_L(n) asm volatile("s_waitcnt lgkmcnt(" #n ")" ::: "memory")
#define PG8_BAR __builtin_amdgcn_s_barrier()
#define PG8_SCHED __builtin_amdgcn_sched_barrier(0)
    Unit cur, nxt; int ui = 0;
    if (!S.next(0, cur)) return;
    f32x4 acc[2][2][4][2];
    bf16x8 At[4][2], B0[2][2], B1[2][2];
    const size_t khb = Epi::HAS_MID ? (size_t)K * 2 : 0;
    const char* cA = (const char*)g.A + (size_t)cur.pm * tstepA + (Epi::HAS_MID ? cur.kh * khb : 0); const char* cB = (const char*)g.Bt + (size_t)cur.pn * tstep + (Epi::HAS_MID ? cur.kh * khb : 0);
    S.a_ready(cur);
    if constexpr (SP2) {
        PG8_STAGE(PG8_SB(0, 0), cB, voffB); PG8_STAGE(PG8_SB(0, 1), cB + hstep, voffB); PG8_STAGE(PG8_SA(0, 0), cA, voffA); PG8_STAGE(PG8_SA(0, 1), cA + hstepA, voffA);
        if (wr == 1) PG8_BAR;
        PG8_WAIT_V(2); PG8_BAR;
        PG8_STAGE(PG8_SB(1, 0), cB + kstep, voffB); PG8_STAGE(PG8_SA(1, 0), cA + kstep, voffA); PG8_STAGE(PG8_SB(1, 1), cB + hstep + kstep, voffB);
        PG8_WAIT_V(6); PG8_BAR;
    } else {
        PG8_STAGE(PG8_SB(0, 0), cB, voffB); PG8_STAGE(PG8_SA(0, 0), cA, voffA); PG8_STAGE(PG8_SB(0, 1), cB + hstep, voffB); PG8_STAGE(PG8_SA(0, 1), cA + hstepA, voffA);
        if (wr == 1) PG8_BAR;
        PG8_WAIT_V(4); PG8_BAR;
        PG8_STAGE(PG8_SB(1, 0), cB + kstep, voffB); PG8_STAGE(PG8_SA(1, 0), cA + kstep, voffA); PG8_STAGE(PG8_SB(1, 1), cB + hstep + kstep, voffB);
        PG8_WAIT_V(6); PG8_BAR;
    }
#pragma unroll
    for (int a = 0; a < 2; ++a)
#pragma unroll
        for (int b = 0; b < 2; ++b)
#pragma unroll
            for (int m = 0; m < 4; ++m)
#pragma unroll
                for (int n = 0; n < 2; ++n) acc[a][b][m][n] = (f32x4){0.f, 0.f, 0.f, 0.f};
    for (;;) {
        const bool has_next = S.next(ui + 1, nxt);
        const char* nA = has_next ? (const char*)g.A + (size_t)nxt.pm * tstepA + (Epi::HAS_MID ? nxt.kh * khb : 0) : cA; const char* nB = has_next ? (const char*)g.Bt + (size_t)nxt.pn * tstep + (Epi::HAS_MID ? nxt.kh * khb : 0) : cB;
        for (int t = 0; t < nt; t += 2) {
            const bool last = (t == nt - 2);
            const char* a1 = cA + (size_t)(t + 1) * kstep;
            const char* a2 = last ? nA : cA + (size_t)(t + 2) * kstep; const char* b2 = last ? nB : cB + (size_t)(t + 2) * kstep;
            const char* a3 = a2 + kstep; const char* b3 = b2 + kstep;
            if (last && has_next) S.a_ready(nxt);
            if constexpr (SP2) {
            PG8_LDB(B0, 0, 0); PG8_LDB(B1, 0, 1); PG8_SCHED; PG8_LDA(At, 0, 0); PG8_STAGE(PG8_SA(1, 1), a1 + hstepA, voffA);
            PG8_WAIT_V(8); PG8_WAIT_L(0); PG8_BAR; PG8_MMA(0, 0, At, B0); PG8_MMA(0, 1, At, B1); PG8_BAR; PG8_SCHED;
            PG8_LDA(At, 0, 1); PG8_STAGE(PG8_SB(0, 0), b2, voffB); PG8_STAGE(PG8_SB(0, 1), b2 + hstep, voffB); PG8_STAGE(PG8_SA(0, 0), a2, voffA);
            PG8_WAIT_V(8); PG8_WAIT_L(0); PG8_BAR; PG8_MMA(1, 0, At, B0); PG8_MMA(1, 1, At, B1); PG8_BAR; PG8_SCHED;
            PG8_LDB(B0, 1, 0); PG8_LDB(B1, 1, 1); PG8_SCHED; PG8_LDA(At, 1, 0); PG8_STAGE(PG8_SA(0, 1), a2 + hstepA, voffA);
            PG8_WAIT_V(8); PG8_WAIT_L(0); PG8_BAR; PG8_MMA(0, 0, At, B0); PG8_MMA(0, 1, At, B1); PG8_BAR; PG8_SCHED;
            PG8_LDA(At, 1, 1); PG8_STAGE(PG8_SB(1, 0), b3, voffB); PG8_STAGE(PG8_SB(1, 1), b3 + hstep, voffB); PG8_STAGE(PG8_SA(1, 0), a3, voffA);
            PG8_WAIT_V(8); PG8_WAIT_L(0); PG8_BAR; PG8_MMA(1, 0, At, B0); PG8_MMA(1, 1, At, B1); PG8_BAR; PG8_SCHED;
            } else {
            PG8_LDB(B0, 0, 0); PG8_SCHED; PG8_LDA(At, 0, 0); PG8_STAGE(PG8_SA(1, 1), a1 + hstepA, voffA);
            PG8_WAIT_L(8); PG8_BAR; PG8_WAIT_L(0); PG8_MMA(0, 0, At, B0); PG8_BAR; PG8_SCHED;
            PG8_LDB(B1, 0, 1); PG8_STAGE(PG8_SB(0, 0), b2, voffB);
            PG8_BAR; PG8_WAIT_L(0); PG8_MMA(0, 1, At, B1); PG8_BAR;
            PG8_LDA(At, 0, 1); PG8_STAGE(PG8_SA(0, 0), a2, voffA);
            PG8_BAR; PG8_WAIT_L(0); PG8_MMA(1, 0, At, B0); PG8_BAR; PG8_SCHED;
            PG8_STAGE(PG8_SB(0, 1), b2 + hstep, voffB);
            PG8_WAIT_V(6); PG8_BAR; PG8_MMA(1, 1, At, B1); PG8_BAR;
            PG8_LDB(B0, 1, 0); PG8_SCHED; PG8_LDA(At, 1, 0); PG8_STAGE(PG8_SA(0, 1), a2 + hstepA, voffA);
            PG8_WAIT_L(8); PG8_BAR; PG8_WAIT_L(0); PG8_MMA(0, 0, At, B0); PG8_BAR; PG8_SCHED;
            PG8_LDB(B1, 1, 1); PG8_STAGE(PG8_SB(1, 0), b3, voffB);
            PG8_BAR; PG8_WAIT_L(0); PG8_MMA(0, 1, At, B1); PG8_BAR;
            PG8_LDA(At, 1, 1); PG8_STAGE(PG8_SA(1, 0), a3, voffA);
            PG8_BAR; PG8_WAIT_L(0); PG8_MMA(1, 0, At, B0); PG8_BAR; PG8_SCHED;
            PG8_STAGE(PG8_SB(1, 1), b3 + hstep, voffB);
            PG8_WAIT_V(6); PG8_BAR; PG8_MMA(1, 1, At, B1); PG8_BAR;
            }
        }
        if constexpr (ALIGN_EPI) { if (wr == 0) PG8_BAR; }
        bool keep_acc = false;
        if constexpr (!Epi::AFTER_DRAIN) {
            if constexpr (Epi::HAS_MID) { if (cur.kh == 0) { E.mid(acc, cur, wr, wc, fr, fq); keep_acc = true; } else E(acc, cur, wr, wc, fr, fq); }
            else E(acc, cur, wr, wc, fr, fq);
            S.done(cur); }
        if (!has_next) break;
        if (!keep_acc)
#pragma unroll
        for (int a = 0; a < 2; ++a)
#pragma unroll
            for (int b = 0; b < 2; ++b)
#pragma unroll
                for (int m = 0; m < 4; ++m)
#pragma unroll
                    for (int n = 0; n < 2; ++n) acc[a][b][m][n] = (f32x4){0.f, 0.f, 0.f, 0.f};
        cur = nxt; cA = nA; cB = nB; ++ui;
        if constexpr (ALIGN_EPI) { if (wr == 1) PG8_BAR; }
    }
    PG8_WAIT_V(0);
    if constexpr (!ALIGN_EPI) { if (wr == 0) PG8_BAR; }
    PG8_BAR;
    if constexpr (Epi::AFTER_DRAIN) { E.fused(acc, cur, wr, wc, fr, fq, lds, wid, lane); S.done(cur); }
#undef PG8_SA
#undef PG8_SB
#undef PG8_STAGE
#undef PG8_LDA
#undef PG8_LDB
#undef PG8_MMA
#undef PG8_WAIT_V
#undef PG8_WAIT_L
#undef PG8_BAR
#undef PG8_SCHED
}
}
namespace att {
#define ALAS __attribute__((address_space(3)))
typedef unsigned short bf16_t;
typedef ALAS char* lptr;
typedef ALAS const char* lcptr;
using bf16x8 = __attribute__((ext_vector_type(8))) short;
using s16x4 = __attribute__((ext_vector_type(4))) short;
using f32x16 = __attribute__((ext_vector_type(16))) float;
using f32x4 = __attribute__((ext_vector_type(4))) float;
using u32x4 = __attribute__((ext_vector_type(4))) unsigned;
constexpr int QB = 256, KVB = 64;
constexpr int KSLOT = 12288, VSLOT = 8192;
constexpr int L_K = 0, L_V = 3 * KSLOT, L_WS = L_V + 3 * VSLOT, L_FLAG = L_WS + 2048, L_OST = L_FLAG + 256, L_END = L_OST + 8 * 4096;
#define SBAR() __builtin_amdgcn_sched_barrier(0)
#define WAIT_BAR0() asm volatile("s_waitcnt vmcnt(0) lgkmcnt(0)\n\ts_barrier" ::: "memory")
__device__ __forceinline__ int crow(int r, int hi) { return (r & 3) + 8 * (r >> 2) + 4 * hi; }
__device__ __forceinline__ void glds(const void* g, lptr l) { __builtin_amdgcn_global_load_lds((const unsigned*)g, (ALAS unsigned*)l, 16, 0, 0); }
typedef float f32x2_t __attribute__((ext_vector_type(2))); typedef __bf16 bf16x2_t __attribute__((ext_vector_type(2)));
__device__ __forceinline__ unsigned cvtpk_s(float lo, float hi) { f32x2_t v = {lo, hi}; bf16x2_t b = __builtin_convertvector(v, bf16x2_t); return __builtin_bit_cast(unsigned, b); }
__device__ __forceinline__ float bfu_lo(unsigned w) { return __uint_as_float(w << 16); }
__device__ __forceinline__ float bfu_hi(unsigned w) { return __uint_as_float(w & 0xffff0000u); }

template <int ND> __device__ __forceinline__ void qkt(f32x16& p0, f32x16& p1, lcptr Kslot, const bf16x8* qr, const f32x16& c0, int r32, int hi) {
    lcptr kb = Kslot + hi * 1024 + r32 * 16;
#pragma unroll
    for (int d0 = 0; d0 < ND; ++d0) {
        const bf16x8 b0 = *(const ALAS bf16x8*)(kb + d0 * 2048);
        const bf16x8 b1 = *(const ALAS bf16x8*)(kb + d0 * 2048 + 512);
        if (d0 == 0) { p0 = __builtin_amdgcn_mfma_f32_32x32x16_bf16(b0, qr[0], c0, 0, 0, 0); p1 = __builtin_amdgcn_mfma_f32_32x32x16_bf16(b1, qr[0], c0, 0, 0, 0); }
        else { p0 = __builtin_amdgcn_mfma_f32_32x32x16_bf16(b0, qr[d0], p0, 0, 0, 0); p1 = __builtin_amdgcn_mfma_f32_32x32x16_bf16(b1, qr[d0], p1, 0, 0, 0); }
    }
}
__device__ __forceinline__ void pv(f32x16* o, int vb, bf16x8 pa0, bf16x8 pa1, bf16x8 pa2, bf16x8 pa3) {
#pragma unroll
    for (int d0 = 0; d0 < 2; ++d0) { s16x4 lo[4], hi[4];
#pragma unroll
        for (int ks = 0; ks < 4; ++ks) {
            asm volatile("ds_read_b64_tr_b16 %0,%1 offset:%c2" : "=&v"(lo[ks]) : "v"(vb), "i"(d0 * 4096 + ks * 1024) : "memory");
            asm volatile("ds_read_b64_tr_b16 %0,%1 offset:%c2" : "=&v"(hi[ks]) : "v"(vb), "i"(d0 * 4096 + ks * 1024 + 512) : "memory"); }
        asm volatile("s_waitcnt lgkmcnt(0)" ::: "memory"); SBAR();
#define PK(k) (bf16x8){lo[k][0], lo[k][1], lo[k][2], lo[k][3], hi[k][0], hi[k][1], hi[k][2], hi[k][3]}
        o[d0] = __builtin_amdgcn_mfma_f32_32x32x16_bf16(pa0, PK(0), o[d0], 0, 0, 0);
        o[d0] = __builtin_amdgcn_mfma_f32_32x32x16_bf16(pa1, PK(1), o[d0], 0, 0, 0);
        o[d0] = __builtin_amdgcn_mfma_f32_32x32x16_bf16(pa2, PK(2), o[d0], 0, 0, 0);
        o[d0] = __builtin_amdgcn_mfma_f32_32x32x16_bf16(pa3, PK(3), o[d0], 0, 0, 0);
#undef PK
    }
}
typedef short v4i16_t __attribute__((ext_vector_type(4)));
__device__ __forceinline__ s16x4 vtr(lcptr p) { return __builtin_bit_cast(s16x4, __builtin_amdgcn_ds_read_tr16_b64_v4i16((ALAS v4i16_t*)p)); }
__device__ __forceinline__ void pv2(f32x16* o, lcptr vp, bf16x8 pa0, bf16x8 pa1, bf16x8 pa2, bf16x8 pa3) {
#pragma unroll
    for (int d0 = 0; d0 < 2; ++d0) { bf16x8 vb[4];
#pragma unroll
        for (int ks = 0; ks < 4; ++ks) { const s16x4 lo = vtr(vp + d0 * 4096 + ks * 1024), hi = vtr(vp + d0 * 4096 + ks * 1024 + 512); vb[ks] = __builtin_shufflevector(lo, hi, 0, 1, 2, 3, 4, 5, 6, 7); }
        o[d0] = __builtin_amdgcn_mfma_f32_32x32x16_bf16(pa0, vb[0], o[d0], 0, 0, 0);
        o[d0] = __builtin_amdgcn_mfma_f32_32x32x16_bf16(pa1, vb[1], o[d0], 0, 0, 0);
        o[d0] = __builtin_amdgcn_mfma_f32_32x32x16_bf16(pa2, vb[2], o[d0], 0, 0, 0);
        o[d0] = __builtin_amdgcn_mfma_f32_32x32x16_bf16(pa3, vb[3], o[d0], 0, 0, 0);
    }
}
__device__ __forceinline__ float xhalf_max(float m) { auto rr = __builtin_amdgcn_permlane32_swap(__float_as_uint(m), __float_as_uint(m), false, false); return __builtin_fmaxf(__uint_as_float(rr[0]), __uint_as_float(rr[1])); }
__device__ __forceinline__ float xhalf_sum(float m) { auto rr = __builtin_amdgcn_permlane32_swap(__float_as_uint(m), __float_as_uint(m), false, false); return __uint_as_float(rr[0]) + __uint_as_float(rr[1]); }
#define PKW(P, B) cvtpk_s(P[B], P[B + 1])
__device__ __forceinline__ void store_o(const f32x16* o, const float* rs, lptr shm, int wid, int lane, int r32, int hi, bf16_t* Ow, int opitch) {
    ALAS bf16_t* stg = (ALAS bf16_t*)(shm + L_OST) + wid * 2048;
#pragma unroll
    for (int r = 0; r < 16; ++r) { const int orow = crow(r, hi);
#pragma unroll
        for (int d0 = 0; d0 < 2; ++d0) stg[orow * 64 + d0 * 32 + r32] = (bf16_t)(cvtpk_s(o[d0][r] * rs[r], 0.f) & 0xffffu); }
    asm volatile("s_waitcnt lgkmcnt(0)" ::: "memory");
#pragma unroll
    for (int i = 0; i < 4; ++i) { const int row = i * 8 + (lane >> 3), ch = lane & 7; const u32x4 v = *(const ALAS u32x4*)(stg + row * 64 + ch * 8); *(u32x4*)(Ow + (long)row * opitch + ch * 8) = v; }
}

__device__ __forceinline__ float max3f(float a, float b, float c) { float r; asm("v_max3_f32 %0, %1, %2, %3" : "=v"(r) : "v"(a), "v"(b), "v"(c)); return r; }
template <bool BAND, bool HAS_NEXT>
__device__ __forceinline__ void mla_step(f32x16& pc0, f32x16& pc1, f32x16& pn0, f32x16& pn1, f32x16* o, f32x16& negm, float& mhat, float& l_reg,
                                         lcptr Knext, int vb, const bf16x8* qr, ALAS float* wsf, int jb, int qrel, int r32, int hi) {
    if constexpr (BAND) { const int kb = 64 * jb + 4 * hi;
#pragma unroll
        for (int r = 0; r < 16; ++r) { const int kv = kb + (r & 3) + 8 * (r >> 2); if (kv > qrel) pc0[r] = -INFINITY; if (kv + 32 > qrel) pc1[r] = -INFINITY; } }
    float rm;
    if constexpr (!BAND) {
        float a = max3f(pc0[0], pc0[1], pc1[0]), b2 = max3f(pc0[2], pc0[3], pc1[1]); a = max3f(a, pc1[2], pc1[3]);
#pragma unroll
        for (int r = 4; r < 16; r += 4) { a = max3f(a, pc0[r], pc0[r + 1]); b2 = max3f(b2, pc0[r + 2], pc0[r + 3]); a = max3f(a, pc1[r], pc1[r + 1]); b2 = max3f(b2, pc1[r + 2], pc1[r + 3]); }
        rm = max3f(a, b2, b2);
    } else {
        rm = __builtin_fmaxf(pc0[0], pc1[0]);
#pragma unroll
        for (int r = 1; r < 16; ++r) rm = __builtin_fmaxf(rm, __builtin_fmaxf(pc0[r], pc1[r]));
    }
    rm = xhalf_max(rm);
    if (__builtin_expect(__any(rm > 8.0f), 0)) {
        const float dl = __builtin_fmaxf(rm, 0.f); mhat += dl;
#pragma unroll
        for (int r = 0; r < 16; ++r) { pc0[r] -= dl; pc1[r] -= dl; negm[r] = -mhat; }
        const float f = __builtin_amdgcn_exp2f(-dl); l_reg *= f; if (hi == 0) wsf[r32] = f;
        asm volatile("s_waitcnt lgkmcnt(0)" ::: "memory");
#pragma unroll
        for (int g = 0; g < 4; ++g) { const f32x4 fv = *(const ALAS f32x4*)(wsf + 8 * g + 4 * hi);
#pragma unroll
            for (int i = 0; i < 4; ++i) { o[0][4 * g + i] *= fv[i]; o[1][4 * g + i] *= fv[i]; } }
    }
    if constexpr (HAS_NEXT) qkt<6>(pn0, pn1, Knext, qr, negm, r32, hi);
    float sacc = 0.f;
#pragma unroll
    for (int r = 0; r < 16; ++r) { pc0[r] = __builtin_amdgcn_exp2f(pc0[r]); pc1[r] = __builtin_amdgcn_exp2f(pc1[r]); sacc += pc0[r] + pc1[r]; }
    l_reg += sacc;
    const u32x4 pw0 = (u32x4){PKW(pc0, 0), PKW(pc0, 2), PKW(pc0, 4), PKW(pc0, 6)}, pw1 = (u32x4){PKW(pc0, 8), PKW(pc0, 10), PKW(pc0, 12), PKW(pc0, 14)};
    const u32x4 pw2 = (u32x4){PKW(pc1, 0), PKW(pc1, 2), PKW(pc1, 4), PKW(pc1, 6)}, pw3 = (u32x4){PKW(pc1, 8), PKW(pc1, 10), PKW(pc1, 12), PKW(pc1, 14)};
    if constexpr (HAS_NEXT) {
#pragma unroll
        for (int i = 0; i < 12; ++i) { __builtin_amdgcn_sched_group_barrier(0x008, 1, 0); __builtin_amdgcn_sched_group_barrier(0x002, 8, 0); }
    }
    pv2(o, (lcptr)(uintptr_t)(unsigned)vb, __builtin_bit_cast(bf16x8, pw0), __builtin_bit_cast(bf16x8, pw1), __builtin_bit_cast(bf16x8, pw2), __builtin_bit_cast(bf16x8, pw3));
}
__device__ __forceinline__ void mla_unit(int b, int h, int qb, const bf16_t* Q, const bf16_t* KV, const bf16_t* KPE, const float* COS, const float* SIN, bf16_t* OA, lptr shm) {
    int tid_ = threadIdx.x; asm volatile("" : "+v"(tid_));
    const int tid = tid_, lane = tid & 63, r32 = lane & 31, hi = lane >> 5; const int wid = __builtin_amdgcn_readfirstlane(tid >> 6);
    const long rowbase = (long)b * SEQ; const int q0 = qb * QB;
    const bf16_t* Qw = Q + (rowbase + q0 + wid * 32) * 768 + h * 96;
    const bf16_t* Kh = KV + rowbase * 1024 + h * 128; const bf16_t* Vh = Kh + 64;
    ALAS float* wsf = (ALAS float*)(shm + L_WS) + wid * 64;
    const bf16_t* ksrc = Kh + (long)lane * 1024 + wid * 8;
    const bf16_t* kpsrc = KPE + (rowbase + lane) * 32 + (wid & 3) * 8;
    const bf16_t* vsrc = Vh + (long)(16 * (wid & 3) + (lane >> 2)) * 1024 + (wid >> 2) * 32 + (lane & 3) * 8;
    const int vb0 = (int)(unsigned)(uintptr_t)(shm + L_V) + ((lane >> 4) & 1) * 32 + (lane & 3) * 8 + (4 * hi + ((lane & 15) >> 2)) * 64;
#define MLA_DMA(t, slot) do { glds(ksrc + (long)(t) * KVB * 1024, shm + L_K + (slot) * KSLOT + wid * 1024); \
        if (wid < 4) glds(kpsrc + (long)(t) * KVB * 32, shm + L_K + (slot) * KSLOT + 8192 + wid * 1024); \
        glds(vsrc + (long)(t) * KVB * 1024, shm + L_V + (slot) * VSLOT + wid * 1024); } while (0)
    const int NT = (q0 + QB) / KVB;
    const int Tw = NT - 3 + (wid >> 1);
    MLA_DMA(0, 0); MLA_DMA(1, 1);
    bf16x8 qr[6];
#pragma unroll
    for (int d0 = 0; d0 < 4; ++d0) qr[d0] = *(const bf16x8*)(Qw + (long)r32 * 768 + d0 * 16 + hi * 8);
    {
        const u32x4 x1 = *(const u32x4*)(Qw + (long)r32 * 768 + 64 + hi * 8), x2 = *(const u32x4*)(Qw + (long)r32 * 768 + 80 + hi * 8);
        const float* cp = COS + (rowbase + q0 + wid * 32 + r32) * 16 + hi * 8; const float* sp = SIN + (rowbase + q0 + wid * 32 + r32) * 16 + hi * 8;
        const f32x4 c0 = *(const f32x4*)cp, c1 = *(const f32x4*)(cp + 4), s0 = *(const f32x4*)sp, s1 = *(const f32x4*)(sp + 4);
        const float a[8] = {bfu_lo(x1.x), bfu_hi(x1.x), bfu_lo(x1.y), bfu_hi(x1.y), bfu_lo(x1.z), bfu_hi(x1.z), bfu_lo(x1.w), bfu_hi(x1.w)};
        const float bb[8] = {bfu_lo(x2.x), bfu_hi(x2.x), bfu_lo(x2.y), bfu_hi(x2.y), bfu_lo(x2.z), bfu_hi(x2.z), bfu_lo(x2.w), bfu_hi(x2.w)};
        const float cc[8] = {c0[0], c0[1], c0[2], c0[3], c1[0], c1[1], c1[2], c1[3]}, ss[8] = {s0[0], s0[1], s0[2], s0[3], s1[0], s1[1], s1[2], s1[3]};
        u32x4 o1, o2;
        o1.x = cvtpk_s(a[0] * cc[0] - bb[0] * ss[0], a[1] * cc[1] - bb[1] * ss[1]); o1.y = cvtpk_s(a[2] * cc[2] - bb[2] * ss[2], a[3] * cc[3] - bb[3] * ss[3]);
        o1.z = cvtpk_s(a[4] * cc[4] - bb[4] * ss[4], a[5] * cc[5] - bb[5] * ss[5]); o1.w = cvtpk_s(a[6] * cc[6] - bb[6] * ss[6], a[7] * cc[7] - bb[7] * ss[7]);
        o2.x = cvtpk_s(a[0] * ss[0] + bb[0] * cc[0], a[1] * ss[1] + bb[1] * cc[1]); o2.y = cvtpk_s(a[2] * ss[2] + bb[2] * cc[2], a[3] * ss[3] + bb[3] * cc[3]);
        o2.z = cvtpk_s(a[4] * ss[4] + bb[4] * cc[4], a[5] * ss[5] + bb[5] * cc[5]); o2.w = cvtpk_s(a[6] * ss[6] + bb[6] * cc[6], a[7] * ss[7] + bb[7] * cc[7]);
        qr[4] = __builtin_bit_cast(bf16x8, o1); qr[5] = __builtin_bit_cast(bf16x8, o2);
    }
    float mhat = 0.f, l_reg = 0.f; f32x16 o[2]; o[0] = f32x16{}; o[1] = f32x16{}; f32x16 negm = f32x16{};
    const int qrel = wid * 32 + r32;
    f32x16 pA0, pA1, pB0, pB1;
    WAIT_BAR0();
    MLA_DMA(2, 2);
    qkt<6>(pA0, pA1, (lcptr)(shm + L_K), qr, negm, r32, hi);
    if (NT == 4) { const int kb = 4 * hi;
#pragma unroll
        for (int r = 0; r < 16; ++r) { const int kv = kb + (r & 3) + 8 * (r >> 2); if (kv > qrel) pA0[r] = -INFINITY; if (kv + 32 > qrel) pA1[r] = -INFINITY; } }
    { float rm = __builtin_fmaxf(pA0[0], pA1[0]);
#pragma unroll
      for (int r = 1; r < 16; ++r) rm = __builtin_fmaxf(rm, __builtin_fmaxf(pA0[r], pA1[r]));
      rm = xhalf_max(rm); mhat = rm;
#pragma unroll
      for (int r = 0; r < 16; ++r) { pA0[r] -= rm; pA1[r] -= rm; negm[r] = -mhat; } }
    int s_cur = 0, s_nxt = 1, s_fre = 2;
#define MLA_SEAM(t_) do { if ((t_) > 0) { WAIT_BAR0(); if ((t_) + 2 < NT) MLA_DMA((t_) + 2, s_fre); } } while (0)
#define MLA_ROT() do { const int x_ = s_cur; s_cur = s_nxt; s_nxt = s_fre; s_fre = x_; } while (0)
    for (int t = 0; t < NT - 4; t += 2) {
        MLA_SEAM(t);
        mla_step<false, true>(pA0, pA1, pB0, pB1, o, negm, mhat, l_reg, (lcptr)(shm + L_K + s_nxt * KSLOT), vb0 + s_cur * VSLOT, qr, wsf, 0, qrel, r32, hi);
        MLA_ROT();
        MLA_SEAM(t + 1);
        mla_step<false, true>(pB0, pB1, pA0, pA1, o, negm, mhat, l_reg, (lcptr)(shm + L_K + s_nxt * KSLOT), vb0 + s_cur * VSLOT, qr, wsf, 0, qrel, r32, hi);
        MLA_ROT();
    }
    for (int t = NT - 4; t < NT; ++t) {
        MLA_SEAM(t);
        if (t < Tw) {
            if (t > NT - 4) qkt<6>(pA0, pA1, (lcptr)(shm + L_K + s_cur * KSLOT), qr, negm, r32, hi);
            mla_step<true, false>(pA0, pA1, pB0, pB1, o, negm, mhat, l_reg, (lcptr)(shm + L_K), vb0 + s_cur * VSLOT, qr, wsf, t - (NT - 4), qrel, r32, hi);
        }
        MLA_ROT();
    }
#undef MLA_SEAM
#undef MLA_ROT
#undef MLA_DMA
    l_reg = xhalf_sum(l_reg);
    if (hi == 0) wsf[32 + r32] = l_reg; asm volatile("s_waitcnt lgkmcnt(0)" ::: "memory");
    float rli[16];
#pragma unroll
    for (int r = 0; r < 16; ++r) rli[r] = __builtin_amdgcn_rcpf(wsf[32 + crow(r, hi)]);
    store_o(o, rli, shm, wid, lane, r32, hi, OA + (rowbase + q0 + wid * 32) * 1024 + h * 64, 1024);
    asm volatile("s_waitcnt lgkmcnt(0)\n\ts_barrier" ::: "memory");
}

__device__ __forceinline__ void sb_unit(int b, int h, int qb, const bf16_t* PROJ, bf16_t* OB, lptr shm) {
    int tid_ = threadIdx.x; asm volatile("" : "+v"(tid_));
    const int tid = tid_, lane = tid & 63, r32 = lane & 31, hi = lane >> 5; const int wid = __builtin_amdgcn_readfirstlane(tid >> 6);
    const long rowbase = (long)b * SEQ; const int q0 = qb * QB;
    const bf16_t* Qw = PROJ + (rowbase + q0 + wid * 32) * DINP + C_QSB + h * 64;
    const bf16_t* Kh = PROJ + rowbase * DINP + C_KSB + h * 64; const bf16_t* Vh = PROJ + rowbase * DINP + C_VSB + h * 64;
    const bf16_t* ksrc = Kh + (long)lane * DINP + wid * 8;
    const bf16_t* vsrc = Vh + (long)(16 * (wid & 3) + (lane >> 2)) * DINP + (wid >> 2) * 32 + (lane & 3) * 8;
    const int vb0 = (int)(unsigned)(uintptr_t)(shm + L_V) + ((lane >> 4) & 1) * 32 + (lane & 3) * 8 + (4 * hi + ((lane & 15) >> 2)) * 64;
    ALAS unsigned* flags = (ALAS unsigned*)(shm + L_FLAG);
#define SB_DMA(t, slot) do { glds(ksrc + (long)(t) * KVB * DINP, shm + L_K + (slot) * KSLOT + wid * 1024); \
        glds(vsrc + (long)(t) * KVB * DINP, shm + L_V + (slot) * VSLOT + wid * 1024); } while (0)
    const int NT = (q0 + QB) / KVB;
    int t = NT - 1;
    SB_DMA(t, 0);
    bf16x8 qr[4];
#pragma unroll
    for (int d0 = 0; d0 < 4; ++d0) qr[d0] = *(const bf16x8*)(Qw + (long)r32 * DINP + d0 * 16 + hi * 8);
    f32x16 o[2]; o[0] = f32x16{}; o[1] = f32x16{}; const f32x16 zero16 = f32x16{};
    float R = 1.0f;
    const int qrel = wid * 32 + r32;
    for (int i = 0;; ++i) {
        WAIT_BAR0();
        if (i > 0) { unsigned all = 1u;
#pragma unroll
            for (int w = 0; w < 8; ++w) all &= flags[((i - 1) & 1) * 8 + w];
            if (all) break; }
        if (t > 0) SB_DMA(t - 1, (i + 1) & 1);
        const int jb = t - (NT - 4);
        const bool skip = (jb >= 0 && 64 * jb >= 32 * wid + 31) || __all(R == 0.0f);
        if (!skip) {
            f32x16 z0, z1;
            qkt<4>(z0, z1, (lcptr)(shm + L_K + (i & 1) * KSLOT), qr, zero16, r32, hi);
            float M0[16], M1[16];
#pragma unroll
            for (int r = 0; r < 16; ++r) {
                const int kv = 64 * jb + crow(r, hi);
                { const float om = __builtin_amdgcn_rcpf(1.0f + __builtin_amdgcn_exp2f(z0[r] * LOG2E)); M0[r] = ((jb >= 0) && (kv >= qrel)) ? 1.0f : om; }
                { const float om = __builtin_amdgcn_rcpf(1.0f + __builtin_amdgcn_exp2f(z1[r] * LOG2E)); M1[r] = ((jb >= 0) && (kv + 32 >= qrel)) ? 1.0f : om; }
            }
            float G[8], PG[8], ST[8];
#pragma unroll
            for (int g = 0; g < 4; ++g) { G[g] = (M0[4 * g] * M0[4 * g + 1]) * (M0[4 * g + 2] * M0[4 * g + 3]); G[4 + g] = (M1[4 * g] * M1[4 * g + 1]) * (M1[4 * g + 2] * M1[4 * g + 3]); }
#pragma unroll
            for (int j = 0; j < 8; ++j) PG[j] = __shfl_xor(G[j], 32);
            ST[7] = 1.0f;
#pragma unroll
            for (int j = 6; j >= 0; --j) ST[j] = ST[j + 1] * (G[j + 1] * PG[j + 1]);
            const float total = ST[0] * (G[0] * PG[0]);
#pragma unroll
            for (int g = 0; g < 4; ++g) {
                { float after = R * ST[g] * (hi == 0 ? PG[g] : 1.0f);
#pragma unroll
                  for (int ii = 3; ii >= 0; --ii) { const float om = M0[4 * g + ii]; z0[4 * g + ii] = __builtin_fmaf(-after, om, after); after *= om; } }
                { float after = R * ST[4 + g] * (hi == 0 ? PG[4 + g] : 1.0f);
#pragma unroll
                  for (int ii = 3; ii >= 0; --ii) { const float om = M1[4 * g + ii]; z1[4 * g + ii] = __builtin_fmaf(-after, om, after); after *= om; } }
            }
            R *= total;
            const u32x4 pw0 = (u32x4){PKW(z0, 0), PKW(z0, 2), PKW(z0, 4), PKW(z0, 6)}, pw1 = (u32x4){PKW(z0, 8), PKW(z0, 10), PKW(z0, 12), PKW(z0, 14)};
            const u32x4 pw2 = (u32x4){PKW(z1, 0), PKW(z1, 2), PKW(z1, 4), PKW(z1, 6)}, pw3 = (u32x4){PKW(z1, 8), PKW(z1, 10), PKW(z1, 12), PKW(z1, 14)};
            SBAR();
            pv(o, vb0 + (i & 1) * VSLOT, __builtin_bit_cast(bf16x8, pw0), __builtin_bit_cast(bf16x8, pw1), __builtin_bit_cast(bf16x8, pw2), __builtin_bit_cast(bf16x8, pw3));
        }
        const unsigned done_w = __all(R == 0.0f) ? 1u : 0u;
        if (lane == 0) flags[(i & 1) * 8 + wid] = done_w;
        if (t == 0) break;
        --t;
    }
#undef SB_DMA
    float one[16];
#pragma unroll
    for (int r = 0; r < 16; ++r) one[r] = 1.0f;
    store_o(o, one, shm, wid, lane, r32, hi, OB + (rowbase + q0 + wid * 32) * 1024 + 512 + h * 64, 1024);
    asm volatile("s_waitcnt lgkmcnt(0)\n\ts_barrier" ::: "memory");
}
#undef PKW
#undef SBAR
#undef WAIT_BAR0
}

#define GAS __attribute__((address_space(1)))
#define LAS __attribute__((address_space(3)))
typedef unsigned short bf16;
typedef unsigned v4u __attribute__((ext_vector_type(4)));
typedef unsigned v2u __attribute__((ext_vector_type(2)));
typedef float f32x4 __attribute__((ext_vector_type(4)));
constexpr int NWAVES = 8;
constexpr size_t MiB = 1u << 20;
constexpr size_t WS_WIN = 2 * MiB, WS_WQB = 11 * MiB, WS_WKVB = 12 * MiB, WS_WBRA = 13 * MiB, WS_WBRB = 14 * MiB, WS_WOUT = 15 * MiB, WS_WGU = 17 * MiB, WS_WDN = 28 * MiB, WS_WPG = 34 * MiB, WS_WPP = 36 * MiB;
constexpr size_t WS_COS = 40 * MiB, WS_SIN = 42 * MiB, WS_KPE = 44 * MiB, WS_PB = 48 * MiB;
constexpr size_t WS_XN = 64 * MiB;
constexpr size_t WS_CQN = 64 * MiB, WS_CKVN = 88 * MiB, WS_OA = 64 * MiB, WS_OB = 96 * MiB;
constexpr size_t WS_PROJ = 128 * MiB;
constexpr size_t WS_ACT = 128 * MiB, WS_EP = 304 * MiB, WS_GS = 368 * MiB;
constexpr size_t WS_Q = 400 * MiB, WS_KV = 448 * MiB;
constexpr size_t WS_MERGED = 448 * MiB, WS_H2B = 448 * MiB, WS_END = 512 * MiB;
static_assert(WS_PROJ + (size_t)NTOK * DINP * 2 <= WS_Q && WS_ACT + (size_t)NTOK * DFF * 2 <= WS_EP && WS_GS + (size_t)NTOK * DM * 2 <= WS_KV && WS_Q + (size_t)NTOK * 768 * 2 <= WS_KV, "ws map");
static_assert(WS_WIN + (size_t)DINP * DM * 2 <= WS_WQB && WS_WGU + (size_t)2 * DFF * DM * 2 <= WS_WDN && WS_WDN + (size_t)DFF * DM * 2 <= WS_WPG, "ws weights");
constexpr int LDS_BYTES = 131072 + 1024;
static_assert(att::L_END <= 131072, "attention LDS");

__device__ __forceinline__ unsigned f2bf(float f) { unsigned u = __builtin_bit_cast(unsigned, f); return (u + 0x7fffu + ((u >> 16) & 1u)) >> 16; }
__device__ __forceinline__ unsigned pk2(float lo, float hi) { return f2bf(lo) | (f2bf(hi) << 16); }
__device__ __forceinline__ float wave_sum(float v) {
#pragma unroll
    for (int o = 1; o < 64; o <<= 1) v += __shfl_xor(v, o);
    return v;
}
__device__ __forceinline__ int dest_row(int mode, int n0) {
    if (mode == 1) {
        if (n0 < 672) return n0;
        if (n0 < 2208) return n0 + 96;
        if (n0 < 3232) { const int j = n0 - 2208; return 2304 + 256 * (j >> 7) + (j & 127); }
        const int j = n0 - 3232; return 2304 + 256 * (j >> 7) + 128 + (j & 127);
    }
    if (mode == 2) return 256 * (n0 >> 7) + (n0 & 127);
    if (mode == 3) return 256 * (n0 >> 7) + 128 + (n0 & 127);
    return n0;
}
__device__ __forceinline__ void transpose_item(const float* W, int K, int N, bf16* WT, int mode, LAS float* scr, int item, int lane, const float* gk = nullptr, int ldk = 0, int koff = 0) {
    const int nblk = N / 32, kb = item / nblk, nb = item % nblk, k0 = 64 * kb, n0 = 32 * nb;
    const int dr = dest_row(mode, n0);
#pragma unroll 8
    for (int i = 0; i < 32; ++i) { const int kk = 2 * i + (lane >> 5); float w = __builtin_nontemporal_load(W + (size_t)(k0 + kk) * N + n0 + (lane & 31)); if (gk) w *= gk[k0 + kk]; scr[kk * 33 + (lane & 31)] = w; }
    asm volatile("s_waitcnt lgkmcnt(0)" ::: "memory");
    const int c = lane & 7;
#pragma unroll
    for (int j = 0; j < 4; ++j) { const int n = (lane >> 3) + 8 * j; const LAS float* s = scr + (8 * c) * 33 + n;
        v4u o; o.x = pk2(s[0 * 33], s[1 * 33]); o.y = pk2(s[2 * 33], s[3 * 33]); o.z = pk2(s[4 * 33], s[5 * 33]); o.w = pk2(s[6 * 33], s[7 * 33]);
        *(v4u*)(WT + (size_t)(dr + n) * (ldk ? ldk : K) + koff + k0 + 8 * c) = o; }
    asm volatile("s_waitcnt lgkmcnt(0)" ::: "memory");
}
template <int R> __device__ __forceinline__ void rms_rows_to_bf16(const float* src, const float* g, bf16* dst, int m0, int mstride, int lane) {
    f32x4 v[R][4]; float s[R];
#pragma unroll
    for (int r = 0; r < R; ++r) { const f32x4* xr = (const f32x4*)(src + (size_t)(m0 + r * mstride) * DM) + lane;
#pragma unroll
        for (int j = 0; j < 4; ++j) v[r][j] = xr[64 * j]; }
    f32x4 gg[4];
#pragma unroll
    for (int j = 0; j < 4; ++j) gg[j] = ((const f32x4*)g + lane)[64 * j];
#pragma unroll
    for (int r = 0; r < R; ++r) { s[r] = 0.f;
#pragma unroll
        for (int j = 0; j < 4; ++j) s[r] += (v[r][j].x * v[r][j].x + v[r][j].y * v[r][j].y) + (v[r][j].z * v[r][j].z + v[r][j].w * v[r][j].w); }
#pragma unroll
    for (int o = 1; o < 64; o <<= 1) {
#pragma unroll
        for (int r = 0; r < R; ++r) s[r] += __shfl_xor(s[r], o); }
#pragma unroll
    for (int r = 0; r < R; ++r) { const float rstd = 1.0f / sqrtf(s[r] * (1.f / DM) + EPS); v2u* o8 = (v2u*)(dst + (size_t)(m0 + r * mstride) * DM) + lane;
#pragma unroll
        for (int j = 0; j < 4; ++j) { v2u w; w.x = pk2(v[r][j].x * rstd * gg[j].x, v[r][j].y * rstd * gg[j].y); w.y = pk2(v[r][j].z * rstd * gg[j].z, v[r][j].w * rstd * gg[j].w); o8[64 * j] = w; } }
}
template <int R> __device__ __forceinline__ void rms_rows_bf16_to_bf16(const bf16* src, const float* g, bf16* dst, int m0, int mstride, int lane) {
    f32x4 v[R][4]; float s[R];
#pragma unroll
    for (int r = 0; r < R; ++r) { const v2u* xr = (const v2u*)(src + (size_t)(m0 + r * mstride) * DM) + lane;
#pragma unroll
        for (int j = 0; j < 4; ++j) { const v2u w = xr[64 * j]; v[r][j] = (f32x4){pg8::bf_lo(w.x), pg8::bf_hi(w.x), pg8::bf_lo(w.y), pg8::bf_hi(w.y)}; } }
    f32x4 gg[4];
#pragma unroll
    for (int j = 0; j < 4; ++j) gg[j] = ((const f32x4*)g + lane)[64 * j];
#pragma unroll
    for (int r = 0; r < R; ++r) { s[r] = 0.f;
#pragma unroll
        for (int j = 0; j < 4; ++j) s[r] += (v[r][j].x * v[r][j].x + v[r][j].y * v[r][j].y) + (v[r][j].z * v[r][j].z + v[r][j].w * v[r][j].w); }
#pragma unroll
    for (int o = 1; o < 64; o <<= 1) {
#pragma unroll
        for (int r = 0; r < R; ++r) s[r] += __shfl_xor(s[r], o); }
#pragma unroll
    for (int r = 0; r < R; ++r) { const float rstd = 1.0f / sqrtf(s[r] * (1.f / DM) + EPS); v2u* o8 = (v2u*)(dst + (size_t)(m0 + r * mstride) * DM) + lane;
#pragma unroll
        for (int j = 0; j < 4; ++j) { v2u w; w.x = pk2(v[r][j].x * rstd * gg[j].x, v[r][j].y * rstd * gg[j].y); w.y = pk2(v[r][j].z * rstd * gg[j].z, v[r][j].w * rstd * gg[j].w); o8[64 * j] = w; } }
}
__device__ __forceinline__ float inv_freq(int j) {
    const float b = (j & 2) ? ((j & 1) ? 0.17782794100389228f : 0.31622776601683794f) : ((j & 1) ? 0.5623413251903491f : 1.0f);
    const float s = (j & 8) ? ((j & 4) ? 0.001f : 0.01f) : ((j & 4) ? 0.1f : 1.0f);
    return b * s;
}


typedef unsigned gu32_t;
#define XB_TMO      128
#define XB_XCNT(j)  (256  + 64 * (j))
#define XB_XSUB(j)  (1280 + 64 * (j))
#define XB_XGEN(j)  (2304 + 64 * (j))
#define XB_TOP      3328
#define XB_TOPGEN   3392
#define XCD_BAR_WORDS 3456
#define XB_SPIN_CAP (1u << 18)

__device__ __forceinline__ unsigned xb_ld(unsigned* p)              { return __hip_atomic_load(p, __ATOMIC_RELAXED, __HIP_MEMORY_SCOPE_AGENT); }
__device__ __forceinline__ unsigned xb_add(unsigned* p, unsigned v) { return __hip_atomic_fetch_add(p, v, __ATOMIC_RELAXED, __HIP_MEMORY_SCOPE_AGENT); }
__device__ __forceinline__ unsigned xb_xcc_id() { return (unsigned)__builtin_amdgcn_s_getreg((3 << 11) | 20) & 0xFu; }
#define XB_SPIN(cond, bar) do { unsigned _sp = 0; while (cond) { __builtin_amdgcn_s_sleep(1); \
    if ((++_sp & 255u) == 0u) { if (xb_ld(&(bar)[XB_TMO])) break; if (_sp > XB_SPIN_CAP) { atomicAdd(&(bar)[XB_TMO], 1u); break; } } } } while (0)

struct XcdBarrier {
    unsigned* bar; unsigned x;
    volatile LAS unsigned* st;
};

__device__ __forceinline__ XcdBarrier xcd_barrier_post(unsigned* bar, volatile LAS unsigned* st) {
    XcdBarrier b; b.bar = bar; b.x = xb_xcc_id(); b.st = st;
    if (threadIdx.x == 0) (void)xb_add(&bar[XB_XCNT(b.x)], 1u);
    return b;
}
__device__ __forceinline__ void xcd_barrier_complete(unsigned* bar, unsigned x, unsigned& nloc, unsigned& nx) {
    const unsigned G = gridDim.x * gridDim.y * gridDim.z;
    unsigned sum, cnt, mine, sp = 0u;
    for (;;) {
        sum = 0u; cnt = 0u; mine = 0u;
#pragma unroll
        for (unsigned j = 0; j < 16; ++j) { const unsigned c = xb_ld(&bar[XB_XCNT(j)]); sum += c; cnt += (c > 0u) ? 1u : 0u; mine = (j == x) ? c : mine; }
        if (sum == G) break;
        __builtin_amdgcn_s_sleep(1);
        if ((++sp & 255u) == 0u) { if (xb_ld(&bar[XB_TMO])) break; if (sp > XB_SPIN_CAP) { atomicAdd(&bar[XB_TMO], 1u); break; } }
    }
    nloc = mine > 0u ? mine : 1u; nx = cnt > 0u ? cnt : 1u;
}

__device__ __forceinline__ void xcd_barrier(const XcdBarrier& b) {
    asm volatile("s_waitcnt vmcnt(0)" ::: "memory");
    __syncthreads();
    if (threadIdx.x == 0) {
        unsigned* bar = b.bar;
        __builtin_amdgcn_s_waitcnt(0);
        unsigned nloc = b.st[0], nx = b.st[1];
        if (nloc == 0u) { xcd_barrier_complete(bar, b.x, nloc, nx); b.st[0] = nloc; b.st[1] = nx; }
        const unsigned old = xb_add(&bar[XB_XSUB(b.x)], 1u);
        const unsigned gen = old / nloc;
        if (old + 1u == (gen + 1u) * nloc) {
            __builtin_amdgcn_fence(__ATOMIC_RELEASE, "agent");
            asm volatile("s_waitcnt vmcnt(0)" ::: "memory");
            const unsigned og = xb_add(&bar[XB_TOP], 1u);
            const unsigned tg = og / nx;
            if (og + 1u == (tg + 1u) * nx) xb_add(&bar[XB_TOPGEN], 1u);
            else XB_SPIN(xb_ld(&bar[XB_TOPGEN]) == tg, bar);
            __builtin_amdgcn_fence(__ATOMIC_ACQUIRE, "agent");
            xb_add(&bar[XB_XGEN(b.x)], 1u);
            asm volatile("s_waitcnt vmcnt(0)" ::: "memory");
        } else {
            XB_SPIN(xb_ld(&bar[XB_XGEN(b.x)]) == gen, bar);
            __builtin_amdgcn_fence(__ATOMIC_ACQUIRE, "agent");
            asm volatile("s_waitcnt vmcnt(0)" ::: "memory");
        }
    }
    __syncthreads();
}

struct Args { const void* in[20]; float* out; unsigned char* ws; };
#define CG_SYNC() do { asm volatile("s_waitcnt vmcnt(0) lgkmcnt(0)" ::: "memory"); __syncthreads(); grid.sync(); \
    if (threadIdx.x < 64) { __builtin_amdgcn_fence(__ATOMIC_ACQUIRE, "agent"); asm volatile("s_waitcnt vmcnt(0)" ::: "memory"); }     \
    __syncthreads(); } while (0)
#define GRID_SYNC() xcd_barrier(xbar)

__global__ void __launch_bounds__(NWAVES * 64, 2) fwd_megakernel(Args args) {
    extern __shared__ __attribute__((aligned(16))) unsigned char lds_raw[];
    cg::grid_group grid = cg::this_grid();
    LAS unsigned char* lds = (LAS unsigned char*)lds_raw;
    int tid = threadIdx.x, lane = tid & 63; const int wave = __builtin_amdgcn_readfirstlane(tid >> 6);
    const int G = gridDim.x, bx = blockIdx.x;
    const int vcu = (G % 8 == 0) ? (bx % 8) * (G / 8) + bx / 8 : bx;
    const int gw = vcu * NWAVES + wave, NGW = G * NWAVES;
    int gt = bx * (NWAVES * 64) + tid; const int NGT = G * NWAVES * 64;
    unsigned char* ws = args.ws;
    volatile LAS unsigned* MISC = (volatile LAS unsigned*)(lds + 131072);
    if (tid < 64) MISC[tid] = 0u;
    __syncthreads();
    XcdBarrier xbar = xcd_barrier_post((unsigned*)ws + 1024, MISC + 8);
    const float* x = (const float*)args.in[0]; const float* pin = (const float*)args.in[1]; const int* positions = (const int*)args.in[2];
    const float* g_mix = (const float*)args.in[3]; const float* w_in = (const float*)args.in[4]; const float* g_q_a = (const float*)args.in[5]; const float* w_q_b = (const float*)args.in[6];
    const float* g_kv_a = (const float*)args.in[7]; const float* w_kv_b = (const float*)args.in[8]; const float* w_br_mla = (const float*)args.in[9]; const float* w_br_sb = (const float*)args.in[10];
    const float* w_out = (const float*)args.in[11]; const float* g_ffn = (const float*)args.in[12]; const float* w_ffn_gate = (const float*)args.in[13]; const float* w_ffn_up = (const float*)args.in[14];
    const float* w_ffn_down = (const float*)args.in[15]; const float* w_ple_gate = (const float*)args.in[16]; const float* w_ple_proj = (const float*)args.in[17]; const float* g_ple = (const float*)args.in[18];
    const float* g_final = (const float*)args.in[19];
    float* H = args.out;
    unsigned char* wsq = ws;
#define NEWPHASE() do { wsq = ws; asm volatile("" : "+s"(wsq)); tid = threadIdx.x; asm volatile("" : "+v"(tid)); lane = tid & 63; gt = bx * (NWAVES * 64) + tid; } while (0)
#define WIN ((bf16*)(wsq + (WS_WIN)))
#define WQB ((bf16*)(wsq + (WS_WQB)))
#define WKVB ((bf16*)(wsq + (WS_WKVB)))
#define WBRA ((bf16*)(wsq + (WS_WBRA)))
#define WBRB ((bf16*)(wsq + (WS_WBRB)))
#define WOUT ((bf16*)(wsq + (WS_WOUT)))
#define WGU ((bf16*)(wsq + (WS_WGU)))
#define WDN ((bf16*)(wsq + (WS_WDN)))
#define WPG ((bf16*)(wsq + (WS_WPG)))
#define WPP ((bf16*)(wsq + (WS_WPP)))
#define SSQ ((float*)(wsq + (37 * MiB)))
#define SSKV ((float*)(wsq + (46 * MiB)))
#define COS ((float*)(wsq + (WS_COS)))
#define SIN ((float*)(wsq + (WS_SIN)))
#define KPE ((bf16*)(wsq + (WS_KPE)))
#define PB ((bf16*)(wsq + (WS_PB)))
#define XN ((bf16*)(wsq + (WS_XN)))
#define CQN ((bf16*)(wsq + (WS_CQN)))
#define CKVN ((bf16*)(wsq + (WS_CKVN)))
#define OA ((bf16*)(wsq + (WS_OA)))
#define OB ((bf16*)(wsq + (WS_OB)))
#define PROJ ((bf16*)(wsq + (WS_PROJ)))
#define ACT ((bf16*)(wsq + (WS_ACT)))
#define EP ((bf16*)(wsq + (WS_XN)))
#define GS ((bf16*)(wsq + (WS_GS)))
#define H1B ((bf16*)(wsq + (WS_EP)))
#define Qb ((bf16*)(wsq + (WS_Q)))
#define KVb ((bf16*)(wsq + (WS_KV)))
#define MERGED ((bf16*)(wsq + (WS_MERGED)))
#define H2B ((bf16*)(wsq + (WS_H2B)))

    NEWPHASE();
    {
        LAS float* scr = (LAS float*)(lds + wave * 16384);
        constexpr int I_IN = 16 * 133, I_QB = 6 * 24, I_KVB = 4 * 32, I_BR = 8 * 32, I_OUT = 16 * 32, I_G = 16 * 88, I_DN = 44 * 32, I_PG = 16 * 32, I_PP = 4 * 32;
        constexpr int NITEMS = I_IN + I_QB + I_KVB + 2 * I_BR + I_OUT + 2 * I_G + I_DN + I_PG + I_PP;
        for (int it = gw; it < NITEMS; it += NGW) {
            int r = it;
            if (r < I_IN) { transpose_item(w_in, 1024, 4256, WIN, 1, scr, r, lane); continue; } r -= I_IN;
            if (r < I_QB) { transpose_item(w_q_b, 384, 768, WQB, 0, scr, r, lane, g_q_a); continue; } r -= I_QB;
            if (r < I_KVB) { transpose_item(w_kv_b, 256, 1024, WKVB, 0, scr, r, lane, g_kv_a); continue; } r -= I_KVB;
            if (r < I_BR) { transpose_item(w_br_mla, 512, 1024, WBRA, 0, scr, r, lane, nullptr, 1024, 0); continue; } r -= I_BR;
            if (r < I_BR) { transpose_item(w_br_sb, 512, 1024, WBRA, 0, scr, r, lane, nullptr, 1024, 512); continue; } r -= I_BR;
            if (r < I_OUT) { transpose_item(w_out, 1024, 1024, WOUT, 0, scr, r, lane); continue; } r -= I_OUT;
            if (r < I_G) { transpose_item(w_ffn_gate, 1024, 2816, WGU, 2, scr, r, lane); continue; } r -= I_G;
            if (r < I_G) { transpose_item(w_ffn_up, 1024, 2816, WGU, 3, scr, r, lane); continue; } r -= I_G;
            if (r < I_DN) { transpose_item(w_ffn_down, 2816, 1024, WDN, 0, scr, r, lane); continue; } r -= I_DN;
            if (r < I_PG) { transpose_item(w_ple_gate, 1024, 1024, WPG, 0, scr, r, lane); continue; } r -= I_PG;
            transpose_item(w_ple_proj, 256, 1024, WPP, 0, scr, r, lane);
        }
        for (int i = gt; i < 96 * 1024 / 8; i += NGT) *(v4u*)(WIN + (size_t)672 * 1024 + (size_t)i * 8) = (v4u){0u, 0u, 0u, 0u};
        for (int m = gw; m < NTOK; m += 4 * NGW) rms_rows_to_bf16<4>(x, g_mix, XN, m, NGW, lane);
        for (int i = gt; i < NTOK * PLE / 8; i += NGT) { const f32x4 a = __builtin_nontemporal_load((const f32x4*)(pin + (size_t)i * 8)), b = __builtin_nontemporal_load((const f32x4*)(pin + (size_t)i * 8 + 4));
            v4u o; o.x = pk2(a.x, a.y); o.y = pk2(a.z, a.w); o.z = pk2(b.x, b.y); o.w = pk2(b.z, b.w); *(v4u*)(PB + (size_t)i * 8) = o; }
        for (int i = gt; i < NTOK * 16; i += NGT) { const int m = i >> 4, j = i & 15; const float ang = (float)positions[m] * inv_freq(j);
            const double rev = (double)ang * 0.15915494309189535; const float fr = (float)(rev - __builtin_floor(rev));
            COS[i] = __builtin_amdgcn_cosf(fr); SIN[i] = __builtin_amdgcn_sinf(fr); }
    }
    if (__builtin_expect(args.ws == nullptr, 0)) CG_SYNC();
    GRID_SYNC();

    NEWPHASE();
    { pg8::Gemm g{XN, WIN, NTOK, DINP, DM}; pg8::StaticOrder S; S.init(NTOK, DINP, G, bx);
      pg8::Epi<pg8::M_PROJ> E{PROJ, DINP, nullptr, 0, nullptr, nullptr, 1.f, (float*)ws, 0, 0.f};
      pg8::gemm_phase<pg8::Epi<pg8::M_PROJ>, pg8::StaticOrder, true, true>(lds, g, S, E); }
    GRID_SYNC();


    NEWPHASE();
    { pg8::Gemm g{PROJ + C_CQ, WQB, NTOK, 768, QRANK, DINP}; pg8::StaticOrder S; S.init(NTOK, 768, G, bx);
      pg8::Epi<pg8::M_SCALER> E{Qb, 768, nullptr, 0, nullptr, nullptr, MLA_C2, SSQ, 12, 1.f / QRANK};
      pg8::gemm_phase<pg8::Epi<pg8::M_SCALER>, pg8::StaticOrder, true, true>(lds, g, S, E); }
    { pg8::Gemm g{PROJ + C_CKV, WKVB, NTOK, 1024, KVRANK, DINP}; pg8::StaticOrder S; S.init(NTOK, 1024, G, bx);
      pg8::Epi<pg8::M_SCALER> E{KVb, 1024, nullptr, 0, nullptr, nullptr, 1.f, SSKV, 8, 1.f / KVRANK};
      pg8::gemm_phase<pg8::Epi<pg8::M_SCALER>, pg8::StaticOrder, true, true>(lds, g, S, E); }
    GRID_SYNC();

    NEWPHASE();
    for (int i = 0;; ++i) { const int idx = i * G + vcu; if (idx >= 1024) break;
        const int rnd = idx >> 8, v = idx & 255, bh = v >> 2, s = v & 3; const int qb = (rnd == 0) ? 15 - s : (rnd == 1) ? 8 + s : (rnd == 2) ? 7 - s : s;
        att::mla_unit(bh >> 3, bh & 7, qb, Qb, KVb, KPE, COS, SIN, OA, (att::lptr)lds); }
    for (int i = 0;; ++i) { const int idx = i * G + vcu; if (idx >= 1024) break;
        const int rnd = idx >> 8, v = idx & 255, bh = v >> 2, s = v & 3; const int qb = (rnd == 0) ? 15 - s : (rnd == 1) ? 8 + s : (rnd == 2) ? 7 - s : s;
        att::sb_unit(bh >> 3, bh & 7, qb, PROJ, OA, (att::lptr)lds); }
    GRID_SYNC();

    NEWPHASE();
    { pg8::Gemm g{OA, WBRA, NTOK, 1024, 512, 1024, 1024}; pg8::SplitOrder S; S.base.init(NTOK, 1024, G, bx);
      pg8::Epi<pg8::M_GATEF> E{MERGED, 1024, PROJ + C_GA, DINP, nullptr, nullptr, 1.f, nullptr, 0, 0.f};
      pg8::gemm_phase<pg8::Epi<pg8::M_GATEF>, pg8::SplitOrder, true, true>(lds, g, S, E); }
    GRID_SYNC();

    NEWPHASE();
    { pg8::Gemm g{MERGED, WOUT, NTOK, 1024, 1024}; pg8::StaticOrder S; S.init(NTOK, 1024, G, bx);
      pg8::Epi<pg8::M_RES> E{H1B, 1024, nullptr, 0, x, nullptr, 1.f, nullptr, 0, 0.f};
      pg8::gemm_phase<pg8::Epi<pg8::M_RES>, pg8::StaticOrder, true, true>(lds, g, S, E); }
    GRID_SYNC();

    NEWPHASE();
    { int tid7 = threadIdx.x; asm volatile("" : "+v"(tid7)); const int lane7 = tid7 & 63;
      for (int m = gw; m < NTOK; m += 4 * NGW) rms_rows_bf16_to_bf16<4>(H1B, g_ffn, XN, m, NGW, lane7); }
    GRID_SYNC();

    NEWPHASE();
    { pg8::Gemm g{XN, WGU, NTOK, 2 * DFF, DM}; pg8::StaticOrder S; S.init(NTOK, 2 * DFF, G, bx);
      pg8::Epi<pg8::M_SWIGLU> E{ACT, DFF, nullptr, 0, nullptr, nullptr, 1.f, nullptr, 0, 0.f};
      pg8::gemm_phase<pg8::Epi<pg8::M_SWIGLU>, pg8::StaticOrder, true, true>(lds, g, S, E); }
    GRID_SYNC();

    NEWPHASE();
    { pg8::Gemm g{ACT, WDN, NTOK, 1024, DFF}; pg8::StaticOrder S; S.init(NTOK, 1024, G, bx);
      pg8::Epi<pg8::M_RES2> E{H2B, 1024, H1B, 1024, nullptr, nullptr, 1.f, nullptr, 0, 0.f};
      pg8::gemm_phase<pg8::Epi<pg8::M_RES2>, pg8::StaticOrder, true, true>(lds, g, S, E); }
    { pg8::Gemm g{PB, WPP, NTOK, 1024, PLE}; pg8::StaticOrder S; S.init(NTOK, 1024, G, bx);
      pg8::Epi<pg8::M_SCALE> E{EP, 1024, nullptr, 0, nullptr, nullptr, 1.f, nullptr, 0, 0.f};
      pg8::gemm_phase<pg8::Epi<pg8::M_SCALE>, pg8::StaticOrder, false, true>(lds, g, S, E); }
    GRID_SYNC();

    NEWPHASE();
    { pg8::Gemm g{H2B, WPG, NTOK, 1024, 1024}; pg8::StaticOrder S; S.init(NTOK, 1024, G, bx);
      pg8::Epi<pg8::M_SIG> E{GS, 1024, nullptr, 0, nullptr, nullptr, 1.f, nullptr, 0, 0.f};
      pg8::gemm_phase<pg8::Epi<pg8::M_SIG>, pg8::StaticOrder, true, true>(lds, g, S, E); }
    GRID_SYNC();

    NEWPHASE();
    int tid11 = threadIdx.x; asm volatile("" : "+v"(tid11)); const int lane11 = tid11 & 63;
    for (int m0 = gw; m0 < NTOK; m0 += 2 * NGW) {
        f32x4 v[2][4], e[2][4], gsv[2][4]; float se[2], s3[2];
#pragma unroll
        for (int r = 0; r < 2; ++r) { const size_t m = (size_t)(m0 + r * NGW);
            const v2u* hr = (const v2u*)(H2B + m * DM) + lane11; const v2u* er = (const v2u*)(EP + m * DM) + lane11; const v2u* sr = (const v2u*)(GS + m * DM) + lane11;
#pragma unroll
            for (int j = 0; j < 4; ++j) { const v2u wh = __builtin_nontemporal_load(hr + 64 * j); v[r][j] = (f32x4){pg8::bf_lo(wh.x), pg8::bf_hi(wh.x), pg8::bf_lo(wh.y), pg8::bf_hi(wh.y)}; const v2u w = __builtin_nontemporal_load(er + 64 * j); const v2u w2 = __builtin_nontemporal_load(sr + 64 * j);
                e[r][j] = (f32x4){pg8::bf_lo(w.x), pg8::bf_hi(w.x), pg8::bf_lo(w.y), pg8::bf_hi(w.y)}; gsv[r][j] = (f32x4){pg8::bf_lo(w2.x), pg8::bf_hi(w2.x), pg8::bf_lo(w2.y), pg8::bf_hi(w2.y)}; } }
        f32x4 gp4[4], gf4[4];
#pragma unroll
        for (int j = 0; j < 4; ++j) { gp4[j] = ((const f32x4*)g_ple + lane11)[64 * j]; gf4[j] = ((const f32x4*)g_final + lane11)[64 * j]; }
#pragma unroll
        for (int r = 0; r < 2; ++r) { se[r] = 0.f;
#pragma unroll
            for (int j = 0; j < 4; ++j) se[r] += (e[r][j].x * e[r][j].x + e[r][j].y * e[r][j].y) + (e[r][j].z * e[r][j].z + e[r][j].w * e[r][j].w); }
#pragma unroll
        for (int o = 1; o < 64; o <<= 1) { se[0] += __shfl_xor(se[0], o); se[1] += __shfl_xor(se[1], o); }
#pragma unroll
        for (int r = 0; r < 2; ++r) { const float rse = 1.0f / sqrtf(se[r] * (1.f / DM) + EPS); s3[r] = 0.f;
#pragma unroll
            for (int j = 0; j < 4; ++j) { v[r][j] = v[r][j] + gsv[r][j] * (e[r][j] * rse * gp4[j]); s3[r] += (v[r][j].x * v[r][j].x + v[r][j].y * v[r][j].y) + (v[r][j].z * v[r][j].z + v[r][j].w * v[r][j].w); } }
#pragma unroll
        for (int o = 1; o < 64; o <<= 1) { s3[0] += __shfl_xor(s3[0], o); s3[1] += __shfl_xor(s3[1], o); }
#pragma unroll
        for (int r = 0; r < 2; ++r) { const float rs3 = 1.0f / sqrtf(s3[r] * (1.f / DM) + EPS); f32x4* hw = (f32x4*)(H + (size_t)(m0 + r * NGW) * DM) + lane11;
#pragma unroll
            for (int j = 0; j < 4; ++j) __builtin_nontemporal_store(v[r][j] * rs3 * gf4[j], hw + 64 * j); }
    }
}

#undef WIN
#undef WQB
#undef WKVB
#undef WBRA
#undef WBRB
#undef WOUT
#undef WGU
#undef WDN
#undef WPG
#undef WPP
#undef SSQ
#undef SSKV
#undef COS
#undef SIN
#undef KPE
#undef PB
#undef XN
#undef CQN
#undef CKVN
#undef OA
#undef OB
#undef PROJ
#undef ACT
#undef EP
#undef GS
#undef H1B
#undef Qb
#undef KVb
#undef MERGED
#undef H2B
#undef NEWPHASE
extern "C" void kernel_launch(void* const* d_in, const int* in_sizes, int n_in, void* d_out, int out_size, void* d_ws, size_t ws_size, hipStream_t stream) {
    static int grid = 0;
    if (grid == 0) {
        if (n_in != 20 || out_size != NTOK * DM || ws_size < WS_END) { fprintf(stderr, "kernel_launch: unexpected shapes (n_in %d out %d ws %zu)\n", n_in, out_size, ws_size); grid = -1; return; }
        int dev = 0, cus = 0, per_cu = 0;
        if (hipGetDevice(&dev) != hipSuccess || hipDeviceGetAttribute(&cus, hipDeviceAttributeMultiprocessorCount, dev) != hipSuccess) { grid = -1; return; }
        if (hipFuncSetAttribute((const void*)fwd_megakernel, hipFuncAttributeMaxDynamicSharedMemorySize, LDS_BYTES) != hipSuccess) { fprintf(stderr, "kernel_launch: hipFuncSetAttribute failed\n"); grid = -1; return; }
        if (hipOccupancyMaxActiveBlocksPerMultiprocessor(&per_cu, (const void*)fwd_megakernel, NWAVES * 64, LDS_BYTES) != hipSuccess || per_cu < 1) { fprintf(stderr, "kernel_launch: occupancy query says %d\n", per_cu); per_cu = 1; }
        (void)hipGetLastError();
        grid = cus;
    }
    if (grid < 0) return;
    if (hipMemsetAsync(d_ws, 0, 65536, stream) != hipSuccess) { fprintf(stderr, "kernel_launch: memset failed\n"); return; }
    Args a{};
    for (int i = 0; i < 20; ++i) a.in[i] = d_in[i];
    a.out = (float*)d_out; a.ws = (unsigned char*)d_ws;
    void* kargs[] = {&a};
    hipError_t e = hipLaunchCooperativeKernel((const void*)fwd_megakernel, dim3(grid), dim3(NWAVES * 64), kargs, LDS_BYTES, stream);
    if (e != hipSuccess) fprintf(stderr, "kernel_launch: cooperative launch failed: %s (grid %d)\n", hipGetErrorString(e), grid);
}
```

```cpp
#include <hip/hip_runtime.h>
#include <hip/hip_cooperative_groups.h>
#include <cstdio>
#include <cstdint>
namespace cg = cooperative_groups;

constexpr int NB = 8, SEQ = 4096, DM = 1024, NTOK = NB * SEQ;
constexpr int PLE = 256, QRANK = 384, KVRANK = 256, ROPE = 32, NH = 8;
constexpr int DFF = 2816, DINP = 4352;
constexpr int C_CQ = 0, C_CKV = 384, C_KPE = 640, C_QSB = 768, C_KSB = 1280, C_VSB = 1792, C_GA = 2304, C_GB = 3328;
constexpr float EPS = 1e-6f;
constexpr float LOG2E = 1.4426950408889634f;
constexpr float MLA_C2 = 0.10206207261596575f * 1.4426950408889634f;

namespace pg8 {
#define PG8_LAS __attribute__((address_space(3)))
typedef unsigned short bf16_t;
typedef short bf16x8 __attribute__((ext_vector_type(8)));
typedef float f32x4 __attribute__((ext_vector_type(4)));
typedef unsigned u32x4 __attribute__((ext_vector_type(4)));
constexpr int BM = 256, BK = 64, HALF = 128, HTB = HALF * BK * 2  , STAGE_BYTES = 8 * HTB, NXCD = 8, WGM = 8;

__host__ __device__ __forceinline__ int lds_byte(int r, int c) { const int st = (r >> 4) * 2 + (c >> 5), rr = r & 15, cc = c & 31, ob = rr * 64 + cc * 2; return st * 1024 + (ob ^ (((ob >> 9) & 1) << 5)); }
__host__ __device__ __forceinline__ void stage_rc(int b, int& R, int& C) { const int st = b / 1024, sb = b % 1024, swz = sb ^ (((sb >> 9) & 1) << 5); R = (st >> 1) * 16 + swz / 64; C = (st & 1) * 32 + (swz % 64) / 2; }
__host__ __device__ __forceinline__ int perm32(int rho) { const int n = rho >> 4, i = rho & 15; return 8 * (i >> 2) + 4 * n + (i & 3); }

struct Unit { int pm, pn, kh; };
struct Gemm { const bf16_t* A; const bf16_t* Bt; int M, N, K; int lda; int ldb; };

struct StaticOrder {
    int nM, nN, nwg, G, c;
    __host__ __device__ void init(int M, int N, int G_, int c_) { nM = M / BM; nN = N / BM; nwg = nM * nN; G = G_; c = c_; }
    __host__ __device__ bool next(int i, Unit& u) const {
        const long L = (long)i * G + c; if (L >= nwg) return false;
        int wgid = (int)L; { const int q = nwg / NXCD, r = nwg % NXCD, xcd = wgid % NXCD, off = wgid / NXCD; wgid = (xcd < r ? xcd * (q + 1) : r * (q + 1) + (xcd - r) * q) + off; }
        const int nig = WGM * nN, gid = wgid / nig, fm = gid * WGM, gsz = (nM - fm) < WGM ? (nM - fm) : WGM;
        u.pm = fm + ((wgid % nig) % gsz); u.pn = (wgid % nig) / gsz; return true;
    }
    __device__ __forceinline__ void a_ready(const Unit&) const {}
    __device__ __forceinline__ void done(const Unit&) const {}
};

typedef float f32x2_c __attribute__((ext_vector_type(2))); typedef __bf16 bf16x2_c __attribute__((ext_vector_type(2)));
__device__ __forceinline__ unsigned cvt_pk_bf16(float lo, float hi) { f32x2_c v = {lo, hi}; bf16x2_c b = __builtin_convertvector(v, bf16x2_c); return __builtin_bit_cast(unsigned, b); }
__device__ __forceinline__ float bf_lo(unsigned w) { return __uint_as_float(w << 16); }
__device__ __forceinline__ float bf_hi(unsigned w) { return __uint_as_float(w & 0xffff0000u); }
__device__ __forceinline__ float sigmoidf_fast(float v) { return __builtin_amdgcn_rcpf(1.0f + __builtin_amdgcn_exp2f(-v * 1.4426950408889634f)); }
__device__ __forceinline__ u32x4 pack8(const f32x4& a, const f32x4& b) { u32x4 w; w.x = cvt_pk_bf16(a[0], a[1]); w.y = cvt_pk_bf16(a[2], a[3]); w.z = cvt_pk_bf16(b[0], b[1]); w.w = cvt_pk_bf16(b[2], b[3]); return w; }
__device__ __forceinline__ void unpack8(const u32x4& w, f32x4& a, f32x4& b) { a = (f32x4){bf_lo(w.x), bf_hi(w.x), bf_lo(w.y), bf_hi(w.y)}; b = (f32x4){bf_lo(w.z), bf_hi(w.z), bf_lo(w.w), bf_hi(w.w)}; }

enum EpiMode { M_GATEF = 9, M_SCALER = 8, M_PROJ = 0, M_SCALE = 1, M_SIG = 2, M_GATE1 = 3, M_GATE2 = 4, M_RES = 5, M_RES2 = 6, M_SWIGLU = 7 };
template <int MODE> struct Epi {
    static constexpr bool PERM = true, AFTER_DRAIN = false, HAS_MID = (MODE == M_GATEF);
    __device__ __forceinline__ void mid(f32x4 (&acc)[2][2][4][2], const Unit& u, int wr, int wc, int fr, int fq) const {
        const unsigned lane_off = (unsigned)(((wr * 64 + fr) * ldg + wc * 32 + 8 * fq) * 2);
#pragma unroll
        for (int ai = 0; ai < 2; ++ai)
#pragma unroll
            for (int m = 0; m < 4; ++m) {
#pragma unroll
                for (int bj = 0; bj < 2; ++bj) { const size_t uni = ((size_t)(u.pm * BM + ai * HALF + m * 16) * ldg + 256 * (2 * u.pn + bj)) * 2;
                    f32x4 a, b; unpack8(*(const u32x4*)((const char*)G + uni + lane_off), a, b);
                    acc[ai][bj][m][0] = acc[ai][bj][m][0] * a; acc[ai][bj][m][1] = acc[ai][bj][m][1] * b; }
                asm volatile("" ::: "memory"); }
    }
    bf16_t* O; int ldo;
    const bf16_t* G; int ldg;
    const float* X; float* H;
    float scale;
    float* SQ;
    int np; float inv_n;
    __device__ __forceinline__ void operator()(const f32x4 (&acc)[2][2][4][2], const Unit& u, int wr, int wc, int fr, int fq) const {
        const int row0 = u.pm * BM + wr * 64 + fr;
#pragma unroll
        for (int ai = 0; ai < 2; ++ai)
#pragma unroll
            for (int m = 0; m < 4; ++m) {
                const size_t row = (size_t)(row0 + ai * HALF + m * 16);
                if constexpr (MODE == M_SWIGLU) {
                    const int col = u.pn * HALF + wc * 32 + 8 * fq;
                    f32x4 g0 = acc[ai][0][m][0], g1 = acc[ai][0][m][1]; const f32x4 u0 = acc[ai][1][m][0], u1 = acc[ai][1][m][1];
#pragma unroll
                    for (int i = 0; i < 4; ++i) { g0[i] = g0[i] * sigmoidf_fast(g0[i]) * u0[i]; g1[i] = g1[i] * sigmoidf_fast(g1[i]) * u1[i]; }
                    *(u32x4*)(O + row * ldo + col) = pack8(g0, g1);
                } else {
                    float rsc = scale;
                    if constexpr (MODE == M_SCALER) { float t = 0.f;
#pragma unroll
                        for (int k = 0; k < 3; ++k) if (4 * k < np) { const f32x4 pz = *(const f32x4*)(SQ + row * np + 4 * k); t += (pz[0] + pz[1]) + (pz[2] + pz[3]); }
                        rsc = scale / sqrtf(t * inv_n + 1e-6f); }
#pragma unroll
                    for (int bj = 0; bj < 2; ++bj) {
                        const int col = u.pn * BM + bj * HALF + wc * 32 + 8 * fq;
                        f32x4 v0 = acc[ai][bj][m][0], v1 = acc[ai][bj][m][1];
                        if constexpr (MODE == M_PROJ) {
                            if (u.pn <= 2) { unsigned char* wsb = (unsigned char*)SQ; float* SQq = (float*)(wsb + 37u * 1048576u); float* SKV = (float*)(wsb + 46u * 1048576u);
                                const float* CS = (const float*)(wsb + 40u * 1048576u); const float* SN = (const float*)(wsb + 42u * 1048576u); bf16_t* KP = (bf16_t*)(wsb + 44u * 1048576u);
                                if (!(u.pn == 2 && bj == 1)) {
                                    float q = (v0[0] * v0[0] + v0[1] * v0[1]) + (v0[2] * v0[2] + v0[3] * v0[3]) + (v1[0] * v1[0] + v1[1] * v1[1]) + (v1[2] * v1[2] + v1[3] * v1[3]);
                                    q += __shfl_xor(q, 16); q += __shfl_xor(q, 32);
                                    if (fq == 0) { if (u.pn == 0) SQq[row * 12 + bj * 4 + wc] = q; else if (u.pn == 1 && bj == 0) SQq[row * 12 + 8 + wc] = q; else if (u.pn == 1) SKV[row * 8 + wc] = q; else SKV[row * 8 + 4 + wc] = q; }
                                } else if (wc == 0) {
                                    const int j0 = 8 * (fq & 1); f32x4 r0, r1;
                                    { const f32x4 c = *(const f32x4*)(CS + row * 16 + j0), sn = *(const f32x4*)(SN + row * 16 + j0);
#pragma unroll
                                      for (int i = 0; i < 4; ++i) { const float xp = __shfl_xor(v0[i], 32); r0[i] = fq < 2 ? v0[i] * c[i] - xp * sn[i] : xp * sn[i] + v0[i] * c[i]; } }
                                    { const f32x4 c = *(const f32x4*)(CS + row * 16 + j0 + 4), sn = *(const f32x4*)(SN + row * 16 + j0 + 4);
#pragma unroll
                                      for (int i = 0; i < 4; ++i) { const float xp = __shfl_xor(v1[i], 32); r1[i] = fq < 2 ? v1[i] * c[i] - xp * sn[i] : xp * sn[i] + v1[i] * c[i]; } }
                                    *(u32x4*)(KP + row * 32 + 8 * fq) = pack8(r0, r1);
                                }
                            }
                            if (u.pn >= 9) {
                                if (bj == 0) { f32x4 a0 = acc[ai][0][m][0], a1 = acc[ai][0][m][1], b0 = acc[ai][1][m][0], b1 = acc[ai][1][m][1];
#pragma unroll
                                    for (int i = 0; i < 4; ++i) { const float sb0 = __builtin_fmaxf(sigmoidf_fast(b0[i]), 1e-30f), sb1 = __builtin_fmaxf(sigmoidf_fast(b1[i]), 1e-30f);
                                        a0[i] = sigmoidf_fast(a0[i]) * __builtin_amdgcn_rcpf(sb0); a1[i] = sigmoidf_fast(a1[i]) * __builtin_amdgcn_rcpf(sb1); b0[i] = sb0; b1[i] = sb1; }
                                    *(u32x4*)(O + row * ldo + col) = pack8(a0, a1); *(u32x4*)(O + row * ldo + col + HALF) = pack8(b0, b1); }
                            } else { if (u.pn == 3 || u.pn == 4) { v0 = v0 * (0.125f * 1.4426950408889634f); v1 = v1 * (0.125f * 1.4426950408889634f); }
                                *(u32x4*)(O + row * ldo + col) = pack8(v0, v1); }
                        } else if constexpr (MODE == M_GATEF) {
                            const unsigned lane_off = (unsigned)(((wr * 64 + fr) * ldg + wc * 32 + 8 * fq) * 2);
                            const size_t uni = ((size_t)(u.pm * BM + ai * HALF + m * 16) * ldg + 256 * (2 * u.pn + bj) + HALF) * 2;
                            f32x4 a, b; unpack8(*(const u32x4*)((const char*)G + uni + lane_off), a, b);
                            *(u32x4*)(O + row * ldo + col) = pack8(v0 * a, v1 * b);
                        } else if constexpr (MODE == M_SCALER) {
                            v0 = v0 * rsc; v1 = v1 * rsc;
                            *(u32x4*)(O + row * ldo + col) = pack8(v0, v1);
                        } else if constexpr (MODE == M_SCALE) {
                            v0 = v0 * scale; v1 = v1 * scale;
                            *(u32x4*)(O + row * ldo + col) = pack8(v0, v1);
                        } else if constexpr (MODE == M_SIG) {
#pragma unroll
                            for (int i = 0; i < 4; ++i) { v0[i] = sigmoidf_fast(v0[i]); v1[i] = sigmoidf_fast(v1[i]); }
                            *(u32x4*)(O + row * ldo + col) = pack8(v0, v1);
                        } else if constexpr (MODE == M_GATE1) {
                            f32x4 a, b; unpack8(*(const u32x4*)(G + row * ldg + col), a, b);
                            v0 = v0 * a; v1 = v1 * b;
                            *(u32x4*)(O + row * ldo + col) = pack8(v0, v1);
                        } else if constexpr (MODE == M_GATE2) {
                            f32x4 a, b, c, d; unpack8(*(const u32x4*)(G + row * ldg + col), a, b); unpack8(*(const u32x4*)(O + row * ldo + col), c, d);
                            v0 = c + v0 * a; v1 = d + v1 * b;
                            *(u32x4*)(O + row * ldo + col) = pack8(v0, v1);
                        } else if constexpr (MODE == M_RES) {
                            const f32x4 x0 = *(const f32x4*)(X + row * DM + col), x1 = *(const f32x4*)(X + row * DM + col + 4);
                            v0 = x0 + v0; v1 = x1 + v1;
                            *(u32x4*)(O + row * ldo + col) = pack8(v0, v1);
                        } else if constexpr (MODE == M_RES2) {
                            f32x4 x0, x1; unpack8(*(const u32x4*)(G + row * ldg + col), x0, x1);
                            v0 = x0 + v0; v1 = x1 + v1;
                            *(u32x4*)(O + row * ldo + col) = pack8(v0, v1);
                        }
                    }
                }
                if (m & 1) asm volatile("" ::: "memory");
            }
    }
};

struct SplitOrder {
    StaticOrder base;
    __device__ bool next(int i, Unit& u) const { const bool ok = base.next(i >> 1, u); u.kh = i & 1; return ok; }
    __device__ __forceinline__ void a_ready(const Unit&) const {}
    __device__ __forceinline__ void done(const Unit&) const {}
};

template <class Epi, class Sched, bool ALIGN_EPI = false, bool SP2 = false>
__device__ __forceinline__ void gemm_phase(PG8_LAS unsigned char* lds, const Gemm g, const Sched& S, const Epi& E) {
    int tid_ = threadIdx.x; asm volatile("" : "+v"(tid_));
    const int tid = tid_, wid = __builtin_amdgcn_readfirstlane(tid >> 6), lane = tid & 63, wr = wid >> 2, wc = wid & 3, fr = lane & 15, fq = lane >> 4;
    const int K = g.K, nt = K / BK, lda = g.lda ? g.lda : g.K, ldb = g.ldb ? g.ldb : g.K;
    unsigned voffA[2], voffB[2];
#pragma unroll
    for (int i = 0; i < 2; ++i) { int R, C; stage_rc(tid * 16 + i * 8192, R, C); const int Rb = Epi::PERM ? ((R & ~31) + perm32(R & 31)) : R;
        voffA[i] = (unsigned)(R * lda + C) * 2u; voffB[i] = (unsigned)(Rb * ldb + C) * 2u; }
    const size_t kstep = (size_t)(BK * 2);
    const size_t hstep = (size_t)HALF * ldb * 2;
    const size_t tstep = 2 * hstep;
    const size_t hstepA = (size_t)HALF * lda * 2, tstepA = 2 * hstepA;
    const unsigned ldsw = (unsigned)wid * 1024u;
    const int aoff = lds_byte(wr * 64 + fr, fq * 8), boff = lds_byte(wc * 32 + fr, fq * 8);
#define PG8_SA(b, h) (((b) * 2 + (h)) * HTB)
#define PG8_SB(b, h) ((4 + (b) * 2 + (h)) * HTB)
#define PG8_STAGE(bufoff, gbase, voff) do { _Pragma("unroll") for (int _i = 0; _i < 2; ++_i) \
        __builtin_amdgcn_global_load_lds((const unsigned*)((const char*)(gbase) + (voff)[_i]), (PG8_LAS unsigned*)(lds + (bufoff) + ldsw + _i * 8192), 16, 0, 0); } while (0)
#define PG8_LDA(dst, b, h) do { _Pragma("unroll") for (int m = 0; m < 4; ++m) _Pragma("unroll") for (int k = 0; k < 2; ++k) dst[m][k] = *(const PG8_LAS bf16x8*)(lds + PG8_SA(b, h) + aoff + m * 2048 + k * 1024); } while (0)
#define PG8_LDB(dst, b, h) do { _Pragma("unroll") for (int n = 0; n < 2; ++n) _Pragma("unroll") for (int k = 0; k < 2; ++k) dst[n][k] = *(const PG8_LAS bf16x8*)(lds + PG8_SB(b, h) + boff + n * 2048 + k * 1024); } while (0)
#define PG8_MMA(ai, bj, At, Bt) do { __builtin_amdgcn_s_setprio(1); _Pragma("unroll") for (int m = 0; m < 4; ++m) _Pragma("unroll") for (int n = 0; n < 2; ++n) _Pragma("unroll") for (int k = 0; k < 2; ++k) \
        acc[ai][bj][m][n] = __builtin_amdgcn_mfma_f32_16x16x32_bf16(Bt[n][k], At[m][k], acc[ai][bj][m][n], 0, 0, 0); __builtin_amdgcn_s_setprio(0); } while (0)
#define PG8_WAIT_V(n) asm volatile("s_waitcnt vmcnt(" #n ")" ::: "memory")
#define PG8_WAIT_L(n) asm volatile("s_waitcnt lgkmcnt(" #n ")" ::: "memory")
#define PG8_BAR __builtin_amdgcn_s_barrier()
#define PG8_SCHED __builtin_amdgcn_sched_barrier(0)
    Unit cur, nxt; int ui = 0;
    if (!S.next(0, cur)) return;
    f32x4 acc[2][2][4][2];
    bf16x8 At[4][2], B0[2][2], B1[2][2];
    const size_t khb = Epi::HAS_MID ? (size_t)K * 2 : 0;
    const char* cA = (const char*)g.A + (size_t)cur.pm * tstepA + (Epi::HAS_MID ? cur.kh * khb : 0); const char* cB = (const char*)g.Bt + (size_t)cur.pn * tstep + (Epi::HAS_MID ? cur.kh * khb : 0);
    S.a_ready(cur);
    if constexpr (SP2) {
        PG8_STAGE(PG8_SB(0, 0), cB, voffB); PG8_STAGE(PG8_SB(0, 1), cB + hstep, voffB); PG8_STAGE(PG8_SA(0, 0), cA, voffA); PG8_STAGE(PG8_SA(0, 1), cA + hstepA, voffA);
        if (wr == 1) PG8_BAR;
        PG8_WAIT_V(2); PG8_BAR;
        PG8_STAGE(PG8_SB(1, 0), cB + kstep, voffB); PG8_STAGE(PG8_SA(1, 0), cA + kstep, voffA); PG8_STAGE(PG8_SB(1, 1), cB + hstep + kstep, voffB);
        PG8_WAIT_V(6); PG8_BAR;
    } else {
        PG8_STAGE(PG8_SB(0, 0), cB, voffB); PG8_STAGE(PG8_SA(0, 0), cA, voffA); PG8_STAGE(PG8_SB(0, 1), cB + hstep, voffB); PG8_STAGE(PG8_SA(0, 1), cA + hstepA, voffA);
        if (wr == 1) PG8_BAR;
        PG8_WAIT_V(4); PG8_BAR;
        PG8_STAGE(PG8_SB(1, 0), cB + kstep, voffB); PG8_STAGE(PG8_SA(1, 0), cA + kstep, voffA); PG8_STAGE(PG8_SB(1, 1), cB + hstep + kstep, voffB);
        PG8_WAIT_V(6); PG8_BAR;
    }
#pragma unroll
    for (int a = 0; a < 2; ++a)
#pragma unroll
        for (int b = 0; b < 2; ++b)
#pragma unroll
            for (int m = 0; m < 4; ++m)
#pragma unroll
                for (int n = 0; n < 2; ++n) acc[a][b][m][n] = (f32x4){0.f, 0.f, 0.f, 0.f};
    for (;;) {
        const bool has_next = S.next(ui + 1, nxt);
        const char* nA = has_next ? (const char*)g.A + (size_t)nxt.pm * tstepA + (Epi::HAS_MID ? nxt.kh * khb : 0) : cA; const char* nB = has_next ? (const char*)g.Bt + (size_t)nxt.pn * tstep + (Epi::HAS_MID ? nxt.kh * khb : 0) : cB;
        for (int t = 0; t < nt; t += 2) {
            const bool last = (t == nt - 2);
            const char* a1 = cA + (size_t)(t + 1) * kstep;
            const char* a2 = last ? nA : cA + (size_t)(t + 2) * kstep; const char* b2 = last ? nB : cB + (size_t)(t + 2) * kstep;
            const char* a3 = a2 + kstep; const char* b3 = b2 + kstep;
            if (last && has_next) S.a_ready(nxt);
            if constexpr (SP2) {
            PG8_LDB(B0, 0, 0); PG8_LDB(B1, 0, 1); PG8_SCHED; PG8_LDA(At, 0, 0); PG8_STAGE(PG8_SA(1, 1), a1 + hstepA, voffA);
            PG8_WAIT_V(8); PG8_WAIT_L(0); PG8_BAR; PG8_MMA(0, 0, At, B0); PG8_MMA(0, 1, At, B1); PG8_BAR; PG8_SCHED;
            PG8_LDA(At, 0, 1); PG8_STAGE(PG8_SB(0, 0), b2, voffB); PG8_STAGE(PG8_SB(0, 1), b2 + hstep, voffB); PG8_STAGE(PG8_SA(0, 0), a2, voffA);
            PG8_WAIT_V(8); PG8_WAIT_L(0); PG8_BAR; PG8_MMA(1, 0, At, B0); PG8_MMA(1, 1, At, B1); PG8_BAR; PG8_SCHED;
            PG8_LDB(B0, 1, 0); PG8_LDB(B1, 1, 1); PG8_SCHED; PG8_LDA(At, 1, 0); PG8_STAGE(PG8_SA(0, 1), a2 + hstepA, voffA);
            PG8_WAIT_V(8); PG8_WAIT_L(0); PG8_BAR; PG8_MMA(0, 0, At, B0); PG8_MMA(0, 1, At, B1); PG8_BAR; PG8_SCHED;
            PG8_LDA(At, 1, 1); PG8_STAGE(PG8_SB(1, 0), b3, voffB); PG8_STAGE(PG8_SB(1, 1), b3 + hstep, voffB); PG8_STAGE(PG8_SA(1, 0), a3, voffA);
            PG8_WAIT_V(8); PG8_WAIT_L(0); PG8_BAR; PG8_MMA(1, 0, At, B0); PG8_MMA(1, 1, At, B1); PG8_BAR; PG8_SCHED;
            } else {
            PG8_LDB(B0, 0, 0); PG8_SCHED; PG8_LDA(At, 0, 0); PG8_STAGE(PG8_SA(1, 1), a1 + hstepA, voffA);
            PG8_WAIT_L(8); PG8_BAR; PG8_WAIT_L(0); PG8_MMA(0, 0, At, B0); PG8_BAR; PG8_SCHED;
            PG8_LDB(B1, 0, 1); PG8_STAGE(PG8_SB(0, 0), b2, voffB);
            PG8_BAR; PG8_WAIT_L(0); PG8_MMA(0, 1, At, B1); PG8_BAR;
            PG8_LDA(At, 0, 1); PG8_STAGE(PG8_SA(0, 0), a2, voffA);
            PG8_BAR; PG8_WAIT_L(0); PG8_MMA(1, 0, At, B0); PG8_BAR; PG8_SCHED;
            PG8_STAGE(PG8_SB(0, 1), b2 + hstep, voffB);
            PG8_WAIT_V(6); PG8_BAR; PG8_MMA(1, 1, At, B1); PG8_BAR;
            PG8_LDB(B0, 1, 0); PG8_SCHED; PG8_LDA(At, 1, 0); PG8_STAGE(PG8_SA(0, 1), a2 + hstepA, voffA);
            PG8_WAIT_L(8); PG8_BAR; PG8_WAIT_L(0); PG8_MMA(0, 0, At, B0); PG8_BAR; PG8_SCHED;
            PG8_LDB(B1, 1, 1); PG8_STAGE(PG8_SB(1, 0), b3, voffB);
            PG8_BAR; PG8_WAIT_L(0); PG8_MMA(0, 1, At, B1); PG8_BAR;
            PG8_LDA(At, 1, 1); PG8_STAGE(PG8_SA(1, 0), a3, voffA);
            PG8_BAR; PG8_WAIT_L(0); PG8_MMA(1, 0, At, B0); PG8_BAR; PG8_SCHED;
            PG8_STAGE(PG8_SB(1, 1), b3 + hstep, voffB);
            PG8_WAIT_V(6); PG8_BAR; PG8_MMA(1, 1, At, B1); PG8_BAR;
            }
        }
        if constexpr (ALIGN_EPI) { if (wr == 0) PG8_BAR; }
        bool keep_acc = false;
        if constexpr (!Epi::AFTER_DRAIN) {
            if constexpr (Epi::HAS_MID) { if (cur.kh == 0) { E.mid(acc, cur, wr, wc, fr, fq); keep_acc = true; } else E(acc, cur, wr, wc, fr, fq); }
            else E(acc, cur, wr, wc, fr, fq);
            S.done(cur); }
        if (!has_next) break;
        if (!keep_acc)
#pragma unroll
        for (int a = 0; a < 2; ++a)
#pragma unroll
            for (int b = 0; b < 2; ++b)
#pragma unroll
                for (int m = 0; m < 4; ++m)
#pragma unroll
                    for (int n = 0; n < 2; ++n) acc[a][b][m][n] = (f32x4){0.f, 0.f, 0.f, 0.f};
        cur = nxt; cA = nA; cB = nB; ++ui;
        if constexpr (ALIGN_EPI) { if (wr == 1) PG8_BAR; }
    }
    PG8_WAIT_V(0);
    if constexpr (!ALIGN_EPI) { if (wr == 0) PG8_BAR; }
    PG8_BAR;
    if constexpr (Epi::AFTER_DRAIN) { E.fused(acc, cur, wr, wc, fr, fq, lds, wid, lane); S.done(cur); }
#undef PG8_SA
#undef PG8_SB
#undef PG8_STAGE
#undef PG8_LDA
#undef PG8_LDB
#undef PG8_MMA
#undef PG8_WAIT_V
#undef PG8_WAIT_L
#undef PG8_BAR
#undef PG8_SCHED
}
}
namespace att {
#define ALAS __attribute__((address_space(3)))
typedef unsigned short bf16_t;
typedef ALAS char* lptr;
typedef ALAS const char* lcptr;
using bf16x8 = __attribute__((ext_vector_type(8))) short;
using s16x4 = __attribute__((ext_vector_type(4))) short;
using f32x16 = __attribute__((ext_vector_type(16))) float;
using f32x4 = __attribute__((ext_vector_type(4))) float;
using u32x4 = __attribute__((ext_vector_type(4))) unsigned;
constexpr int QB = 256, KVB = 64;
constexpr int KSLOT = 12288, VSLOT = 8192;
constexpr int L_K = 0, L_V = 3 * KSLOT, L_WS = L_V + 3 * VSLOT, L_FLAG = L_WS + 2048, L_OST = L_FLAG + 256, L_END = L_OST + 8 * 4096;
#define SBAR() __builtin_amdgcn_sched_barrier(0)
#define WAIT_BAR0() asm volatile("s_waitcnt vmcnt(0) lgkmcnt(0)\n\ts_barrier" ::: "memory")
__device__ __forceinline__ int crow(int r, int hi) { return (r & 3) + 8 * (r >> 2) + 4 * hi; }
__device__ __forceinline__ void glds(const void* g, lptr l) { __builtin_amdgcn_global_load_lds((const unsigned*)g, (ALAS unsigned*)l, 16, 0, 0); }
typedef float f32x2_t __attribute__((ext_vector_type(2))); typedef __bf16 bf16x2_t __attribute__((ext_vector_type(2)));
__device__ __forceinline__ unsigned cvtpk_s(float lo, float hi) { f32x2_t v = {lo, hi}; bf16x2_t b = __builtin_convertvector(v, bf16x2_t); return __builtin_bit_cast(unsigned, b); }
__device__ __forceinline__ float bfu_lo(unsigned w) { return __uint_as_float(w << 16); }
__device__ __forceinline__ float bfu_hi(unsigned w) { return __uint_as_float(w & 0xffff0000u); }

template <int ND> __device__ __forceinline__ void qkt(f32x16& p0, f32x16& p1, lcptr Kslot, const bf16x8* qr, const f32x16& c0, int r32, int hi) {
    lcptr kb = Kslot + hi * 1024 + r32 * 16;
#pragma unroll
    for (int d0 = 0; d0 < ND; ++d0) {
        const bf16x8 b0 = *(const ALAS bf16x8*)(kb + d0 * 2048);
        const bf16x8 b1 = *(const ALAS bf16x8*)(kb + d0 * 2048 + 512);
        if (d0 == 0) { p0 = __builtin_amdgcn_mfma_f32_32x32x16_bf16(b0, qr[0], c0, 0, 0, 0); p1 = __builtin_amdgcn_mfma_f32_32x32x16_bf16(b1, qr[0], c0, 0, 0, 0); }
        else { p0 = __builtin_amdgcn_mfma_f32_32x32x16_bf16(b0, qr[d0], p0, 0, 0, 0); p1 = __builtin_amdgcn_mfma_f32_32x32x16_bf16(b1, qr[d0], p1, 0, 0, 0); }
    }
}
__device__ __forceinline__ void pv(f32x16* o, int vb, bf16x8 pa0, bf16x8 pa1, bf16x8 pa2, bf16x8 pa3) {
#pragma unroll
    for (int d0 = 0; d0 < 2; ++d0) { s16x4 lo[4], hi[4];
#pragma unroll
        for (int ks = 0; ks < 4; ++ks) {
            asm volatile("ds_read_b64_tr_b16 %0,%1 offset:%c2" : "=&v"(lo[ks]) : "v"(vb), "i"(d0 * 4096 + ks * 1024) : "memory");
            asm volatile("ds_read_b64_tr_b16 %0,%1 offset:%c2" : "=&v"(hi[ks]) : "v"(vb), "i"(d0 * 4096 + ks * 1024 + 512) : "memory"); }
        asm volatile("s_waitcnt lgkmcnt(0)" ::: "memory"); SBAR();
#define PK(k) (bf16x8){lo[k][0], lo[k][1], lo[k][2], lo[k][3], hi[k][0], hi[k][1], hi[k][2], hi[k][3]}
        o[d0] = __builtin_amdgcn_mfma_f32_32x32x16_bf16(pa0, PK(0), o[d0], 0, 0, 0);
        o[d0] = __builtin_amdgcn_mfma_f32_32x32x16_bf16(pa1, PK(1), o[d0], 0, 0, 0);
        o[d0] = __builtin_amdgcn_mfma_f32_32x32x16_bf16(pa2, PK(2), o[d0], 0, 0, 0);
        o[d0] = __builtin_amdgcn_mfma_f32_32x32x16_bf16(pa3, PK(3), o[d0], 0, 0, 0);
#undef PK
    }
}
typedef short v4i16_t __attribute__((ext_vector_type(4)));
__device__ __forceinline__ s16x4 vtr(lcptr p) { return __builtin_bit_cast(s16x4, __builtin_amdgcn_ds_read_tr16_b64_v4i16((ALAS v4i16_t*)p)); }
__device__ __forceinline__ void pv2(f32x16* o, lcptr vp, bf16x8 pa0, bf16x8 pa1, bf16x8 pa2, bf16x8 pa3) {
#pragma unroll
    for (int d0 = 0; d0 < 2; ++d0) { bf16x8 vb[4];
#pragma unroll
        for (int ks = 0; ks < 4; ++ks) { const s16x4 lo = vtr(vp + d0 * 4096 + ks * 1024), hi = vtr(vp + d0 * 4096 + ks * 1024 + 512); vb[ks] = __builtin_shufflevector(lo, hi, 0, 1, 2, 3, 4, 5, 6, 7); }
        o[d0] = __builtin_amdgcn_mfma_f32_32x32x16_bf16(pa0, vb[0], o[d0], 0, 0, 0);
        o[d0] = __builtin_amdgcn_mfma_f32_32x32x16_bf16(pa1, vb[1], o[d0], 0, 0, 0);
        o[d0] = __builtin_amdgcn_mfma_f32_32x32x16_bf16(pa2, vb[2], o[d0], 0, 0, 0);
        o[d0] = __builtin_amdgcn_mfma_f32_32x32x16_bf16(pa3, vb[3], o[d0], 0, 0, 0);
    }
}
__device__ __forceinline__ float xhalf_max(float m) { auto rr = __builtin_amdgcn_permlane32_swap(__float_as_uint(m), __float_as_uint(m), false, false); return __builtin_fmaxf(__uint_as_float(rr[0]), __uint_as_float(rr[1])); }
__device__ __forceinline__ float xhalf_sum(float m) { auto rr = __builtin_amdgcn_permlane32_swap(__float_as_uint(m), __float_as_uint(m), false, false); return __uint_as_float(rr[0]) + __uint_as_float(rr[1]); }
#define PKW(P, B) cvtpk_s(P[B], P[B + 1])
__device__ __forceinline__ void store_o(const f32x16* o, const float* rs, lptr shm, int wid, int lane, int r32, int hi, bf16_t* Ow, int opitch) {
    ALAS bf16_t* stg = (ALAS bf16_t*)(shm + L_OST) + wid * 2048;
#pragma unroll
    for (int r = 0; r < 16; ++r) { const int orow = crow(r, hi);
#pragma unroll
        for (int d0 = 0; d0 < 2; ++d0) stg[orow * 64 + d0 * 32 + r32] = (bf16_t)(cvtpk_s(o[d0][r] * rs[r], 0.f) & 0xffffu); }
    asm volatile("s_waitcnt lgkmcnt(0)" ::: "memory");
#pragma unroll
    for (int i = 0; i < 4; ++i) { const int row = i * 8 + (lane >> 3), ch = lane & 7; const u32x4 v = *(const ALAS u32x4*)(stg + row * 64 + ch * 8); *(u32x4*)(Ow + (long)row * opitch + ch * 8) = v; }
}

__device__ __forceinline__ float max3f(float a, float b, float c) { float r; asm("v_max3_f32 %0, %1, %2, %3" : "=v"(r) : "v"(a), "v"(b), "v"(c)); return r; }
template <bool BAND, bool HAS_NEXT>
__device__ __forceinline__ void mla_step(f32x16& pc0, f32x16& pc1, f32x16& pn0, f32x16& pn1, f32x16* o, f32x16& negm, float& mhat, float& l_reg,
                                         lcptr Knext, int vb, const bf16x8* qr, ALAS float* wsf, int jb, int qrel, int r32, int hi) {
    if constexpr (BAND) { const int kb = 64 * jb + 4 * hi;
#pragma unroll
        for (int r = 0; r < 16; ++r) { const int kv = kb + (r & 3) + 8 * (r >> 2); if (kv > qrel) pc0[r] = -INFINITY; if (kv + 32 > qrel) pc1[r] = -INFINITY; } }
    float rm;
    if constexpr (!BAND) {
        float a = max3f(pc0[0], pc0[1], pc1[0]), b2 = max3f(pc0[2], pc0[3], pc1[1]); a = max3f(a, pc1[2], pc1[3]);
#pragma unroll
        for (int r = 4; r < 16; r += 4) { a = max3f(a, pc0[r], pc0[r + 1]); b2 = max3f(b2, pc0[r + 2], pc0[r + 3]); a = max3f(a, pc1[r], pc1[r + 1]); b2 = max3f(b2, pc1[r + 2], pc1[r + 3]); }
        rm = max3f(a, b2, b2);
    } else {
        rm = __builtin_fmaxf(pc0[0], pc1[0]);
#pragma unroll
        for (int r = 1; r < 16; ++r) rm = __builtin_fmaxf(rm, __builtin_fmaxf(pc0[r], pc1[r]));
    }
    rm = xhalf_max(rm);
    if (__builtin_expect(__any(rm > 8.0f), 0)) {
        const float dl = __builtin_fmaxf(rm, 0.f); mhat += dl;
#pragma unroll
        for (int r = 0; r < 16; ++r) { pc0[r] -= dl; pc1[r] -= dl; negm[r] = -mhat; }
        const float f = __builtin_amdgcn_exp2f(-dl); l_reg *= f; if (hi == 0) wsf[r32] = f;
        asm volatile("s_waitcnt lgkmcnt(0)" ::: "memory");
#pragma unroll
        for (int g = 0; g < 4; ++g) { const f32x4 fv = *(const ALAS f32x4*)(wsf + 8 * g + 4 * hi);
#pragma unroll
            for (int i = 0; i < 4; ++i) { o[0][4 * g + i] *= fv[i]; o[1][4 * g + i] *= fv[i]; } }
    }
    if constexpr (HAS_NEXT) qkt<6>(pn0, pn1, Knext, qr, negm, r32, hi);
    float sacc = 0.f;
#pragma unroll
    for (int r = 0; r < 16; ++r) { pc0[r] = __builtin_amdgcn_exp2f(pc0[r]); pc1[r] = __builtin_amdgcn_exp2f(pc1[r]); sacc += pc0[r] + pc1[r]; }
    l_reg += sacc;
    const u32x4 pw0 = (u32x4){PKW(pc0, 0), PKW(pc0, 2), PKW(pc0, 4), PKW(pc0, 6)}, pw1 = (u32x4){PKW(pc0, 8), PKW(pc0, 10), PKW(pc0, 12), PKW(pc0, 14)};
    const u32x4 pw2 = (u32x4){PKW(pc1, 0), PKW(pc1, 2), PKW(pc1, 4), PKW(pc1, 6)}, pw3 = (u32x4){PKW(pc1, 8), PKW(pc1, 10), PKW(pc1, 12), PKW(pc1, 14)};
    if constexpr (HAS_NEXT) {
#pragma unroll
        for (int i = 0; i < 12; ++i) { __builtin_amdgcn_sched_group_barrier(0x008, 1, 0); __builtin_amdgcn_sched_group_barrier(0x002, 8, 0); }
    }
    pv2(o, (lcptr)(uintptr_t)(unsigned)vb, __builtin_bit_cast(bf16x8, pw0), __builtin_bit_cast(bf16x8, pw1), __builtin_bit_cast(bf16x8, pw2), __builtin_bit_cast(bf16x8, pw3));
}
__device__ __forceinline__ void mla_unit(int b, int h, int qb, const bf16_t* Q, const bf16_t* KV, const bf16_t* KPE, const float* COS, const float* SIN, bf16_t* OA, lptr shm) {
    int tid_ = threadIdx.x; asm volatile("" : "+v"(tid_));
    const int tid = tid_, lane = tid & 63, r32 = lane & 31, hi = lane >> 5; const int wid = __builtin_amdgcn_readfirstlane(tid >> 6);
    const long rowbase = (long)b * SEQ; const int q0 = qb * QB;
    const bf16_t* Qw = Q + (rowbase + q0 + wid * 32) * 768 + h * 96;
    const bf16_t* Kh = KV + rowbase * 1024 + h * 128; const bf16_t* Vh = Kh + 64;
    ALAS float* wsf = (ALAS float*)(shm + L_WS) + wid * 64;
    const bf16_t* ksrc = Kh + (long)lane * 1024 + wid * 8;
    const bf16_t* kpsrc = KPE + (rowbase + lane) * 32 + (wid & 3) * 8;
    const bf16_t* vsrc = Vh + (long)(16 * (wid & 3) + (lane >> 2)) * 1024 + (wid >> 2) * 32 + (lane & 3) * 8;
    const int vb0 = (int)(unsigned)(uintptr_t)(shm + L_V) + ((lane >> 4) & 1) * 32 + (lane & 3) * 8 + (4 * hi + ((lane & 15) >> 2)) * 64;
#define MLA_DMA(t, slot) do { glds(ksrc + (long)(t) * KVB * 1024, shm + L_K + (slot) * KSLOT + wid * 1024); \
        if (wid < 4) glds(kpsrc + (long)(t) * KVB * 32, shm + L_K + (slot) * KSLOT + 8192 + wid * 1024); \
        glds(vsrc + (long)(t) * KVB * 1024, shm + L_V + (slot) * VSLOT + wid * 1024); } while (0)
    const int NT = (q0 + QB) / KVB;
    const int Tw = NT - 3 + (wid >> 1);
    MLA_DMA(0, 0); MLA_DMA(1, 1);
    bf16x8 qr[6];
#pragma unroll
    for (int d0 = 0; d0 < 4; ++d0) qr[d0] = *(const bf16x8*)(Qw + (long)r32 * 768 + d0 * 16 + hi * 8);
    {
        const u32x4 x1 = *(const u32x4*)(Qw + (long)r32 * 768 + 64 + hi * 8), x2 = *(const u32x4*)(Qw + (long)r32 * 768 + 80 + hi * 8);
        const float* cp = COS + (rowbase + q0 + wid * 32 + r32) * 16 + hi * 8; const float* sp = SIN + (rowbase + q0 + wid * 32 + r32) * 16 + hi * 8;
        const f32x4 c0 = *(const f32x4*)cp, c1 = *(const f32x4*)(cp + 4), s0 = *(const f32x4*)sp, s1 = *(const f32x4*)(sp + 4);
        const float a[8] = {bfu_lo(x1.x), bfu_hi(x1.x), bfu_lo(x1.y), bfu_hi(x1.y), bfu_lo(x1.z), bfu_hi(x1.z), bfu_lo(x1.w), bfu_hi(x1.w)};
        const float bb[8] = {bfu_lo(x2.x), bfu_hi(x2.x), bfu_lo(x2.y), bfu_hi(x2.y), bfu_lo(x2.z), bfu_hi(x2.z), bfu_lo(x2.w), bfu_hi(x2.w)};
        const float cc[8] = {c0[0], c0[1], c0[2], c0[3], c1[0], c1[1], c1[2], c1[3]}, ss[8] = {s0[0], s0[1], s0[2], s0[3], s1[0], s1[1], s1[2], s1[3]};
        u32x4 o1, o2;
        o1.x = cvtpk_s(a[0] * cc[0] - bb[0] * ss[0], a[1] * cc[1] - bb[1] * ss[1]); o1.y = cvtpk_s(a[2] * cc[2] - bb[2] * ss[2], a[3] * cc[3] - bb[3] * ss[3]);
        o1.z = cvtpk_s(a[4] * cc[4] - bb[4] * ss[4], a[5] * cc[5] - bb[5] * ss[5]); o1.w = cvtpk_s(a[6] * cc[6] - bb[6] * ss[6], a[7] * cc[7] - bb[7] * ss[7]);
        o2.x = cvtpk_s(a[0] * ss[0] + bb[0] * cc[0], a[1] * ss[1] + bb[1] * cc[1]); o2.y = cvtpk_s(a[2] * ss[2] + bb[2] * cc[2], a[3] * ss[3] + bb[3] * cc[3]);
        o2.z = cvtpk_s(a[4] * ss[4] + bb[4] * cc[4], a[5] * ss[5] + bb[5] * cc[5]); o2.w = cvtpk_s(a[6] * ss[6] + bb[6] * cc[6], a[7] * ss[7] + bb[7] * cc[7]);
        qr[4] = __builtin_bit_cast(bf16x8, o1); qr[5] = __builtin_bit_cast(bf16x8, o2);
    }
    float mhat = 0.f, l_reg = 0.f; f32x16 o[2]; o[0] = f32x16{}; o[1] = f32x16{}; f32x16 negm = f32x16{};
    const int qrel = wid * 32 + r32;
    f32x16 pA0, pA1, pB0, pB1;
    WAIT_BAR0();
    MLA_DMA(2, 2);
    qkt<6>(pA0, pA1, (lcptr)(shm + L_K), qr, negm, r32, hi);
    if (NT == 4) { const int kb = 4 * hi;
#pragma unroll
        for (int r = 0; r < 16; ++r) { const int kv = kb + (r & 3) + 8 * (r >> 2); if (kv > qrel) pA0[r] = -INFINITY; if (kv + 32 > qrel) pA1[r] = -INFINITY; } }
    { float rm = __builtin_fmaxf(pA0[0], pA1[0]);
#pragma unroll
      for (int r = 1; r < 16; ++r) rm = __builtin_fmaxf(rm, __builtin_fmaxf(pA0[r], pA1[r]));
      rm = xhalf_max(rm); mhat = rm;
#pragma unroll
      for (int r = 0; r < 16; ++r) { pA0[r] -= rm; pA1[r] -= rm; negm[r] = -mhat; } }
    int s_cur = 0, s_nxt = 1, s_fre = 2;
#define MLA_SEAM(t_) do { if ((t_) > 0) { WAIT_BAR0(); if ((t_) + 2 < NT) MLA_DMA((t_) + 2, s_fre); } } while (0)
#define MLA_ROT() do { const int x_ = s_cur; s_cur = s_nxt; s_nxt = s_fre; s_fre = x_; } while (0)
    for (int t = 0; t < NT - 4; t += 2) {
        MLA_SEAM(t);
        mla_step<false, true>(pA0, pA1, pB0, pB1, o, negm, mhat, l_reg, (lcptr)(shm + L_K + s_nxt * KSLOT), vb0 + s_cur * VSLOT, qr, wsf, 0, qrel, r32, hi);
        MLA_ROT();
        MLA_SEAM(t + 1);
        mla_step<false, true>(pB0, pB1, pA0, pA1, o, negm, mhat, l_reg, (lcptr)(shm + L_K + s_nxt * KSLOT), vb0 + s_cur * VSLOT, qr, wsf, 0, qrel, r32, hi);
        MLA_ROT();
    }
    for (int t = NT - 4; t < NT; ++t) {
        MLA_SEAM(t);
        if (t < Tw) {
            if (t > NT - 4) qkt<6>(pA0, pA1, (lcptr)(shm + L_K + s_cur * KSLOT), qr, negm, r32, hi);
            mla_step<true, false>(pA0, pA1, pB0, pB1, o, negm, mhat, l_reg, (lcptr)(shm + L_K), vb0 + s_cur * VSLOT, qr, wsf, t - (NT - 4), qrel, r32, hi);
        }
        MLA_ROT();
    }
#undef MLA_SEAM
#undef MLA_ROT
#undef MLA_DMA
    l_reg = xhalf_sum(l_reg);
    if (hi == 0) wsf[32 + r32] = l_reg; asm volatile("s_waitcnt lgkmcnt(0)" ::: "memory");
    float rli[16];
#pragma unroll
    for (int r = 0; r < 16; ++r) rli[r] = __builtin_amdgcn_rcpf(wsf[32 + crow(r, hi)]);
    store_o(o, rli, shm, wid, lane, r32, hi, OA + (rowbase + q0 + wid * 32) * 1024 + h * 64, 1024);
    asm volatile("s_waitcnt lgkmcnt(0)\n\ts_barrier" ::: "memory");
}

__device__ __forceinline__ void sb_unit(int b, int h, int qb, const bf16_t* PROJ, bf16_t* OB, lptr shm) {
    int tid_ = threadIdx.x; asm volatile("" : "+v"(tid_));
    const int tid = tid_, lane = tid & 63, r32 = lane & 31, hi = lane >> 5; const int wid = __builtin_amdgcn_readfirstlane(tid >> 6);
    const long rowbase = (long)b * SEQ; const int q0 = qb * QB;
    const bf16_t* Qw = PROJ + (rowbase + q0 + wid * 32) * DINP + C_QSB + h * 64;
    const bf16_t* Kh = PROJ + rowbase * DINP + C_KSB + h * 64; const bf16_t* Vh = PROJ + rowbase * DINP + C_VSB + h * 64;
    const bf16_t* ksrc = Kh + (long)lane * DINP + wid * 8;
    const bf16_t* vsrc = Vh + (long)(16 * (wid & 3) + (lane >> 2)) * DINP + (wid >> 2) * 32 + (lane & 3) * 8;
    const int vb0 = (int)(unsigned)(uintptr_t)(shm + L_V) + ((lane >> 4) & 1) * 32 + (lane & 3) * 8 + (4 * hi + ((lane & 15) >> 2)) * 64;
    ALAS unsigned* flags = (ALAS unsigned*)(shm + L_FLAG);
#define SB_DMA(t, slot) do { glds(ksrc + (long)(t) * KVB * DINP, shm + L_K + (slot) * KSLOT + wid * 1024); \
        glds(vsrc + (long)(t) * KVB * DINP, shm + L_V + (slot) * VSLOT + wid * 1024); } while (0)
    const int NT = (q0 + QB) / KVB;
    int t = NT - 1;
    SB_DMA(t, 0);
    bf16x8 qr[4];
#pragma unroll
    for (int d0 = 0; d0 < 4; ++d0) qr[d0] = *(const bf16x8*)(Qw + (long)r32 * DINP + d0 * 16 + hi * 8);
    f32x16 o[2]; o[0] = f32x16{}; o[1] = f32x16{}; const f32x16 zero16 = f32x16{};
    float R = 1.0f;
    const int qrel = wid * 32 + r32;
    for (int i = 0;; ++i) {
        WAIT_BAR0();
        if (i > 0) { unsigned all = 1u;
#pragma unroll
            for (int w = 0; w < 8; ++w) all &= flags[((i - 1) & 1) * 8 + w];
            if (all) break; }
        if (t > 0) SB_DMA(t - 1, (i + 1) & 1);
        const int jb = t - (NT - 4);
        const bool skip = (jb >= 0 && 64 * jb >= 32 * wid + 31) || __all(R == 0.0f);
        if (!skip) {
            f32x16 z0, z1;
            qkt<4>(z0, z1, (lcptr)(shm + L_K + (i & 1) * KSLOT), qr, zero16, r32, hi);
            float M0[16], M1[16];
            if (jb >= 0) {
#pragma unroll
                for (int r = 0; r < 16; ++r) { const int kv = 64 * jb + crow(r, hi);
                    { const float om = __builtin_amdgcn_rcpf(1.0f + __builtin_amdgcn_exp2f(z0[r])); M0[r] = (kv >= qrel) ? 1.0f : om; }
                    { const float om = __builtin_amdgcn_rcpf(1.0f + __builtin_amdgcn_exp2f(z1[r])); M1[r] = (kv + 32 >= qrel) ? 1.0f : om; } }
            } else {
#pragma unroll
                for (int r = 0; r < 16; ++r) { M0[r] = __builtin_amdgcn_rcpf(1.0f + __builtin_amdgcn_exp2f(z0[r])); M1[r] = __builtin_amdgcn_rcpf(1.0f + __builtin_amdgcn_exp2f(z1[r])); }
            }
            float G[8], PG[8], ST[8];
#pragma unroll
            for (int g = 0; g < 4; ++g) { G[g] = (M0[4 * g] * M0[4 * g + 1]) * (M0[4 * g + 2] * M0[4 * g + 3]); G[4 + g] = (M1[4 * g] * M1[4 * g + 1]) * (M1[4 * g + 2] * M1[4 * g + 3]); }
#pragma unroll
            for (int j = 0; j < 8; ++j) PG[j] = __shfl_xor(G[j], 32);
            ST[7] = 1.0f;
#pragma unroll
            for (int j = 6; j >= 0; --j) ST[j] = ST[j + 1] * (G[j + 1] * PG[j + 1]);
            const float total = ST[0] * (G[0] * PG[0]);
#pragma unroll
            for (int g = 0; g < 4; ++g) {
                { float after = R * ST[g] * (hi == 0 ? PG[g] : 1.0f);
#pragma unroll
                  for (int ii = 3; ii >= 0; --ii) { const float om = M0[4 * g + ii]; z0[4 * g + ii] = __builtin_fmaf(-after, om, after); after *= om; } }
                { float after = R * ST[4 + g] * (hi == 0 ? PG[4 + g] : 1.0f);
#pragma unroll
                  for (int ii = 3; ii >= 0; --ii) { const float om = M1[4 * g + ii]; z1[4 * g + ii] = __builtin_fmaf(-after, om, after); after *= om; } }
            }
            R *= total;
            const u32x4 pw0 = (u32x4){PKW(z0, 0), PKW(z0, 2), PKW(z0, 4), PKW(z0, 6)}, pw1 = (u32x4){PKW(z0, 8), PKW(z0, 10), PKW(z0, 12), PKW(z0, 14)};
            const u32x4 pw2 = (u32x4){PKW(z1, 0), PKW(z1, 2), PKW(z1, 4), PKW(z1, 6)}, pw3 = (u32x4){PKW(z1, 8), PKW(z1, 10), PKW(z1, 12), PKW(z1, 14)};
            SBAR();
            pv(o, vb0 + (i & 1) * VSLOT, __builtin_bit_cast(bf16x8, pw0), __builtin_bit_cast(bf16x8, pw1), __builtin_bit_cast(bf16x8, pw2), __builtin_bit_cast(bf16x8, pw3));
        }
        const unsigned done_w = __all(R == 0.0f) ? 1u : 0u;
        if (lane == 0) flags[(i & 1) * 8 + wid] = done_w;
        if (t == 0) break;
        --t;
    }
#undef SB_DMA
    float one[16];
#pragma unroll
    for (int r = 0; r < 16; ++r) one[r] = 1.0f;
    store_o(o, one, shm, wid, lane, r32, hi, OB + (rowbase + q0 + wid * 32) * 1024 + 512 + h * 64, 1024);
    asm volatile("s_waitcnt lgkmcnt(0)\n\ts_barrier" ::: "memory");
}
#undef PKW
#undef SBAR
#undef WAIT_BAR0
}

#define GAS __attribute__((address_space(1)))
#define LAS __attribute__((address_space(3)))
typedef unsigned short bf16;
typedef unsigned v4u __attribute__((ext_vector_type(4)));
typedef unsigned v2u __attribute__((ext_vector_type(2)));
typedef float f32x4 __attribute__((ext_vector_type(4)));
constexpr int NWAVES = 8;
constexpr size_t MiB = 1u << 20;
constexpr size_t WS_WIN = 2 * MiB, WS_WQB = 11 * MiB, WS_WKVB = 12 * MiB, WS_WBRA = 13 * MiB, WS_WBRB = 14 * MiB, WS_WOUT = 15 * MiB, WS_WGU = 17 * MiB, WS_WDN = 28 * MiB, WS_WPG = 34 * MiB, WS_WPP = 36 * MiB;
constexpr size_t WS_COS = 40 * MiB, WS_SIN = 42 * MiB, WS_KPE = 44 * MiB, WS_PB = 48 * MiB;
constexpr size_t WS_XN = 64 * MiB;
constexpr size_t WS_CQN = 64 * MiB, WS_CKVN = 88 * MiB, WS_OA = 64 * MiB, WS_OB = 96 * MiB;
constexpr size_t WS_PROJ = 128 * MiB;
constexpr size_t WS_ACT = 128 * MiB, WS_EP = 304 * MiB, WS_GS = 368 * MiB;
constexpr size_t WS_Q = 400 * MiB, WS_KV = 448 * MiB;
constexpr size_t WS_MERGED = 448 * MiB, WS_H2B = 448 * MiB, WS_END = 512 * MiB;
static_assert(WS_PROJ + (size_t)NTOK * DINP * 2 <= WS_Q && WS_ACT + (size_t)NTOK * DFF * 2 <= WS_EP && WS_GS + (size_t)NTOK * DM * 2 <= WS_KV && WS_Q + (size_t)NTOK * 768 * 2 <= WS_KV, "ws map");
static_assert(WS_WIN + (size_t)DINP * DM * 2 <= WS_WQB && WS_WGU + (size_t)2 * DFF * DM * 2 <= WS_WDN && WS_WDN + (size_t)DFF * DM * 2 <= WS_WPG, "ws weights");
constexpr int LDS_BYTES = 131072 + 1024;
static_assert(att::L_END <= 131072, "attention LDS");

__device__ __forceinline__ unsigned f2bf(float f) { unsigned u = __builtin_bit_cast(unsigned, f); return (u + 0x7fffu + ((u >> 16) & 1u)) >> 16; }
__device__ __forceinline__ unsigned pk2(float lo, float hi) { return f2bf(lo) | (f2bf(hi) << 16); }
__device__ __forceinline__ float wave_sum(float v) {
#pragma unroll
    for (int o = 1; o < 64; o <<= 1) v += __shfl_xor(v, o);
    return v;
}
__device__ __forceinline__ int dest_row(int mode, int n0) {
    if (mode == 1) {
        if (n0 < 672) return n0;
        if (n0 < 2208) return n0 + 96;
        if (n0 < 3232) { const int j = n0 - 2208; return 2304 + 256 * (j >> 7) + (j & 127); }
        const int j = n0 - 3232; return 2304 + 256 * (j >> 7) + 128 + (j & 127);
    }
    if (mode == 2) return 256 * (n0 >> 7) + (n0 & 127);
    if (mode == 3) return 256 * (n0 >> 7) + 128 + (n0 & 127);
    return n0;
}
__device__ __forceinline__ void transpose_item(const float* W, int K, int N, bf16* WT, int mode, LAS float* scr, int item, int lane, const float* gk = nullptr, int ldk = 0, int koff = 0) {
    const int nblk = N / 32, kb = item / nblk, nb = item % nblk, k0 = 64 * kb, n0 = 32 * nb;
    const int dr = dest_row(mode, n0);
#pragma unroll 8
    for (int i = 0; i < 32; ++i) { const int kk = 2 * i + (lane >> 5); float w = __builtin_nontemporal_load(W + (size_t)(k0 + kk) * N + n0 + (lane & 31)); if (gk) w *= gk[k0 + kk]; scr[kk * 33 + (lane & 31)] = w; }
    asm volatile("s_waitcnt lgkmcnt(0)" ::: "memory");
    const int c = lane & 7;
#pragma unroll
    for (int j = 0; j < 4; ++j) { const int n = (lane >> 3) + 8 * j; const LAS float* s = scr + (8 * c) * 33 + n;
        v4u o; o.x = pk2(s[0 * 33], s[1 * 33]); o.y = pk2(s[2 * 33], s[3 * 33]); o.z = pk2(s[4 * 33], s[5 * 33]); o.w = pk2(s[6 * 33], s[7 * 33]);
        *(v4u*)(WT + (size_t)(dr + n) * (ldk ? ldk : K) + koff + k0 + 8 * c) = o; }
    asm volatile("s_waitcnt lgkmcnt(0)" ::: "memory");
}
template <int R> __device__ __forceinline__ void rms_rows_to_bf16(const float* src, const float* g, bf16* dst, int m0, int mstride, int lane) {
    f32x4 v[R][4]; float s[R];
#pragma unroll
    for (int r = 0; r < R; ++r) { const f32x4* xr = (const f32x4*)(src + (size_t)(m0 + r * mstride) * DM) + lane;
#pragma unroll
        for (int j = 0; j < 4; ++j) v[r][j] = xr[64 * j]; }
    f32x4 gg[4];
#pragma unroll
    for (int j = 0; j < 4; ++j) gg[j] = ((const f32x4*)g + lane)[64 * j];
#pragma unroll
    for (int r = 0; r < R; ++r) { s[r] = 0.f;
#pragma unroll
        for (int j = 0; j < 4; ++j) s[r] += (v[r][j].x * v[r][j].x + v[r][j].y * v[r][j].y) + (v[r][j].z * v[r][j].z + v[r][j].w * v[r][j].w); }
#pragma unroll
    for (int o = 1; o < 64; o <<= 1) {
#pragma unroll
        for (int r = 0; r < R; ++r) s[r] += __shfl_xor(s[r], o); }
#pragma unroll
    for (int r = 0; r < R; ++r) { const float rstd = 1.0f / sqrtf(s[r] * (1.f / DM) + EPS); v2u* o8 = (v2u*)(dst + (size_t)(m0 + r * mstride) * DM) + lane;
#pragma unroll
        for (int j = 0; j < 4; ++j) { v2u w; w.x = pk2(v[r][j].x * rstd * gg[j].x, v[r][j].y * rstd * gg[j].y); w.y = pk2(v[r][j].z * rstd * gg[j].z, v[r][j].w * rstd * gg[j].w); o8[64 * j] = w; } }
}
template <int R> __device__ __forceinline__ void rms_rows_bf16_to_bf16(const bf16* src, const float* g, bf16* dst, int m0, int mstride, int lane) {
    f32x4 v[R][4]; float s[R];
#pragma unroll
    for (int r = 0; r < R; ++r) { const v2u* xr = (const v2u*)(src + (size_t)(m0 + r * mstride) * DM) + lane;
#pragma unroll
        for (int j = 0; j < 4; ++j) { const v2u w = xr[64 * j]; v[r][j] = (f32x4){pg8::bf_lo(w.x), pg8::bf_hi(w.x), pg8::bf_lo(w.y), pg8::bf_hi(w.y)}; } }
    f32x4 gg[4];
#pragma unroll
    for (int j = 0; j < 4; ++j) gg[j] = ((const f32x4*)g + lane)[64 * j];
#pragma unroll
    for (int r = 0; r < R; ++r) { s[r] = 0.f;
#pragma unroll
        for (int j = 0; j < 4; ++j) s[r] += (v[r][j].x * v[r][j].x + v[r][j].y * v[r][j].y) + (v[r][j].z * v[r][j].z + v[r][j].w * v[r][j].w); }
#pragma unroll
    for (int o = 1; o < 64; o <<= 1) {
#pragma unroll
        for (int r = 0; r < R; ++r) s[r] += __shfl_xor(s[r], o); }
#pragma unroll
    for (int r = 0; r < R; ++r) { const float rstd = 1.0f / sqrtf(s[r] * (1.f / DM) + EPS); v2u* o8 = (v2u*)(dst + (size_t)(m0 + r * mstride) * DM) + lane;
#pragma unroll
        for (int j = 0; j < 4; ++j) { v2u w; w.x = pk2(v[r][j].x * rstd * gg[j].x, v[r][j].y * rstd * gg[j].y); w.y = pk2(v[r][j].z * rstd * gg[j].z, v[r][j].w * rstd * gg[j].w); o8[64 * j] = w; } }
}
__device__ __forceinline__ float inv_freq(int j) {
    const float b = (j & 2) ? ((j & 1) ? 0.17782794100389228f : 0.31622776601683794f) : ((j & 1) ? 0.5623413251903491f : 1.0f);
    const float s = (j & 8) ? ((j & 4) ? 0.001f : 0.01f) : ((j & 4) ? 0.1f : 1.0f);
    return b * s;
}


typedef unsigned gu32_t;
#define XB_TMO      128
#define XB_XCNT(j)  (256  + 64 * (j))
#define XB_XSUB(j)  (1280 + 64 * (j))
#define XB_XGEN(j)  (2304 + 64 * (j))
#define XB_TOP      3328
#define XB_TOPGEN   3392
#define XCD_BAR_WORDS 3456
#define XB_SPIN_CAP (1u << 18)

__device__ __forceinline__ unsigned xb_ld(unsigned* p)              { return __hip_atomic_load(p, __ATOMIC_RELAXED, __HIP_MEMORY_SCOPE_AGENT); }
__device__ __forceinline__ unsigned xb_add(unsigned* p, unsigned v) { return __hip_atomic_fetch_add(p, v, __ATOMIC_RELAXED, __HIP_MEMORY_SCOPE_AGENT); }
__device__ __forceinline__ unsigned xb_xcc_id() { return (unsigned)__builtin_amdgcn_s_getreg((3 << 11) | 20) & 0xFu; }
#define XB_SPIN(cond, bar) do { unsigned _sp = 0; while (cond) { __builtin_amdgcn_s_sleep(1); \
    if ((++_sp & 255u) == 0u) { if (xb_ld(&(bar)[XB_TMO])) break; if (_sp > XB_SPIN_CAP) { atomicAdd(&(bar)[XB_TMO], 1u); break; } } } } while (0)

struct XcdBarrier {
    unsigned* bar; unsigned x;
    volatile LAS unsigned* st;
};

__device__ __forceinline__ XcdBarrier xcd_barrier_post(unsigned* bar, volatile LAS unsigned* st) {
    XcdBarrier b; b.bar = bar; b.x = xb_xcc_id(); b.st = st;
    if (threadIdx.x == 0) (void)xb_add(&bar[XB_XCNT(b.x)], 1u);
    return b;
}
__device__ __forceinline__ void xcd_barrier_complete(unsigned* bar, unsigned x, unsigned& nloc, unsigned& nx) {
    const unsigned G = gridDim.x * gridDim.y * gridDim.z;
    unsigned sum, cnt, mine, sp = 0u;
    for (;;) {
        sum = 0u; cnt = 0u; mine = 0u;
#pragma unroll
        for (unsigned j = 0; j < 16; ++j) { const unsigned c = xb_ld(&bar[XB_XCNT(j)]); sum += c; cnt += (c > 0u) ? 1u : 0u; mine = (j == x) ? c : mine; }
        if (sum == G) break;
        __builtin_amdgcn_s_sleep(1);
        if ((++sp & 255u) == 0u) { if (xb_ld(&bar[XB_TMO])) break; if (sp > XB_SPIN_CAP) { atomicAdd(&bar[XB_TMO], 1u); break; } }
    }
    nloc = mine > 0u ? mine : 1u; nx = cnt > 0u ? cnt : 1u;
}

__device__ __forceinline__ void xcd_barrier(const XcdBarrier& b) {
    asm volatile("s_waitcnt vmcnt(0)" ::: "memory");
    __syncthreads();
    if (threadIdx.x == 0) {
        unsigned* bar = b.bar;
        __builtin_amdgcn_s_waitcnt(0);
        unsigned nloc = b.st[0], nx = b.st[1];
        if (nloc == 0u) { xcd_barrier_complete(bar, b.x, nloc, nx); b.st[0] = nloc; b.st[1] = nx; }
        const unsigned old = xb_add(&bar[XB_XSUB(b.x)], 1u);
        const unsigned gen = old / nloc;
        if (old + 1u == (gen + 1u) * nloc) {
            __builtin_amdgcn_fence(__ATOMIC_RELEASE, "agent");
            asm volatile("s_waitcnt vmcnt(0)" ::: "memory");
            const unsigned og = xb_add(&bar[XB_TOP], 1u);
            const unsigned tg = og / nx;
            if (og + 1u == (tg + 1u) * nx) xb_add(&bar[XB_TOPGEN], 1u);
            else XB_SPIN(xb_ld(&bar[XB_TOPGEN]) == tg, bar);
            __builtin_amdgcn_fence(__ATOMIC_ACQUIRE, "agent");
            xb_add(&bar[XB_XGEN(b.x)], 1u);
            asm volatile("s_waitcnt vmcnt(0)" ::: "memory");
        } else {
            XB_SPIN(xb_ld(&bar[XB_XGEN(b.x)]) == gen, bar);
            __builtin_amdgcn_fence(__ATOMIC_ACQUIRE, "agent");
            asm volatile("s_waitcnt vmcnt(0)" ::: "memory");
        }
    }
    __syncthreads();
}

struct Args { const void* in[20]; float* out; unsigned char* ws; };
#define CG_SYNC() do { asm volatile("s_waitcnt vmcnt(0) lgkmcnt(0)" ::: "memory"); __syncthreads(); grid.sync(); \
    if (threadIdx.x < 64) { __builtin_amdgcn_fence(__ATOMIC_ACQUIRE, "agent"); asm volatile("s_waitcnt vmcnt(0)" ::: "memory"); }     \
    __syncthreads(); } while (0)
#define GRID_SYNC() xcd_barrier(xbar)

__global__ void __launch_bounds__(NWAVES * 64, 2) fwd_megakernel(Args args) {
    extern __shared__ __attribute__((aligned(16))) unsigned char lds_raw[];
    cg::grid_group grid = cg::this_grid();
    LAS unsigned char* lds = (LAS unsigned char*)lds_raw;
    int tid = threadIdx.x, lane = tid & 63; const int wave = __builtin_amdgcn_readfirstlane(tid >> 6);
    const int G = gridDim.x, bx = blockIdx.x;
    const int vcu = (G % 8 == 0) ? (bx % 8) * (G / 8) + bx / 8 : bx;
    const int gw = vcu * NWAVES + wave, NGW = G * NWAVES;
    int gt = bx * (NWAVES * 64) + tid; const int NGT = G * NWAVES * 64;
    unsigned char* ws = args.ws;
    volatile LAS unsigned* MISC = (volatile LAS unsigned*)(lds + 131072);
    if (tid < 64) MISC[tid] = 0u;
    __syncthreads();
    XcdBarrier xbar = xcd_barrier_post((unsigned*)ws + 1024, MISC + 8);
    const float* x = (const float*)args.in[0]; const float* pin = (const float*)args.in[1]; const int* positions = (const int*)args.in[2];
    const float* g_mix = (const float*)args.in[3]; const float* w_in = (const float*)args.in[4]; const float* g_q_a = (const float*)args.in[5]; const float* w_q_b = (const float*)args.in[6];
    const float* g_kv_a = (const float*)args.in[7]; const float* w_kv_b = (const float*)args.in[8]; const float* w_br_mla = (const float*)args.in[9]; const float* w_br_sb = (const float*)args.in[10];
    const float* w_out = (const float*)args.in[11]; const float* g_ffn = (const float*)args.in[12]; const float* w_ffn_gate = (const float*)args.in[13]; const float* w_ffn_up = (const float*)args.in[14];
    const float* w_ffn_down = (const float*)args.in[15]; const float* w_ple_gate = (const float*)args.in[16]; const float* w_ple_proj = (const float*)args.in[17]; const float* g_ple = (const float*)args.in[18];
    const float* g_final = (const float*)args.in[19];
    float* H = args.out;
    unsigned char* wsq = ws;
#define NEWPHASE() do { wsq = ws; asm volatile("" : "+s"(wsq)); tid = threadIdx.x; asm volatile("" : "+v"(tid)); lane = tid & 63; gt = bx * (NWAVES * 64) + tid; } while (0)
#define WIN ((bf16*)(wsq + (WS_WIN)))
#define WQB ((bf16*)(wsq + (WS_WQB)))
#define WKVB ((bf16*)(wsq + (WS_WKVB)))
#define WBRA ((bf16*)(wsq + (WS_WBRA)))
#define WBRB ((bf16*)(wsq + (WS_WBRB)))
#define WOUT ((bf16*)(wsq + (WS_WOUT)))
#define WGU ((bf16*)(wsq + (WS_WGU)))
#define WDN ((bf16*)(wsq + (WS_WDN)))
#define WPG ((bf16*)(wsq + (WS_WPG)))
#define WPP ((bf16*)(wsq + (WS_WPP)))
#define SSQ ((float*)(wsq + (37 * MiB)))
#define SSKV ((float*)(wsq + (46 * MiB)))
#define COS ((float*)(wsq + (WS_COS)))
#define SIN ((float*)(wsq + (WS_SIN)))
#define KPE ((bf16*)(wsq + (WS_KPE)))
#define PB ((bf16*)(wsq + (WS_PB)))
#define XN ((bf16*)(wsq + (WS_XN)))
#define CQN ((bf16*)(wsq + (WS_CQN)))
#define CKVN ((bf16*)(wsq + (WS_CKVN)))
#define OA ((bf16*)(wsq + (WS_OA)))
#define OB ((bf16*)(wsq + (WS_OB)))
#define PROJ ((bf16*)(wsq + (WS_PROJ)))
#define ACT ((bf16*)(wsq + (WS_ACT)))
#define EP ((bf16*)(wsq + (WS_EP)))
#define GS ((bf16*)(wsq + (WS_GS)))
#define H1B ((bf16*)(wsq + (WS_EP)))
#define Qb ((bf16*)(wsq + (WS_Q)))
#define KVb ((bf16*)(wsq + (WS_KV)))
#define MERGED ((bf16*)(wsq + (WS_MERGED)))
#define H2B ((bf16*)(wsq + (WS_H2B)))

    NEWPHASE();
    {
        LAS float* scr = (LAS float*)(lds + wave * 16384);
        constexpr int I_IN = 16 * 133, I_QB = 6 * 24, I_KVB = 4 * 32, I_BR = 8 * 32, I_OUT = 16 * 32, I_G = 16 * 88, I_DN = 44 * 32, I_PG = 16 * 32, I_PP = 4 * 32;
        constexpr int NITEMS = I_IN + I_QB + I_KVB + 2 * I_BR + I_OUT + 2 * I_G + I_DN + I_PG + I_PP;
        for (int it = gw; it < NITEMS; it += NGW) {
            int r = it;
            if (r < I_IN) { transpose_item(w_in, 1024, 4256, WIN, 1, scr, r, lane); continue; } r -= I_IN;
            if (r < I_QB) { transpose_item(w_q_b, 384, 768, WQB, 0, scr, r, lane, g_q_a); continue; } r -= I_QB;
            if (r < I_KVB) { transpose_item(w_kv_b, 256, 1024, WKVB, 0, scr, r, lane, g_kv_a); continue; } r -= I_KVB;
            if (r < I_BR) { transpose_item(w_br_mla, 512, 1024, WBRA, 0, scr, r, lane, nullptr, 1024, 0); continue; } r -= I_BR;
            if (r < I_BR) { transpose_item(w_br_sb, 512, 1024, WBRA, 0, scr, r, lane, nullptr, 1024, 512); continue; } r -= I_BR;
            if (r < I_OUT) { transpose_item(w_out, 1024, 1024, WOUT, 0, scr, r, lane); continue; } r -= I_OUT;
            if (r < I_G) { transpose_item(w_ffn_gate, 1024, 2816, WGU, 2, scr, r, lane); continue; } r -= I_G;
            if (r < I_G) { transpose_item(w_ffn_up, 1024, 2816, WGU, 3, scr, r, lane); continue; } r -= I_G;
            if (r < I_DN) { transpose_item(w_ffn_down, 2816, 1024, WDN, 0, scr, r, lane); continue; } r -= I_DN;
            if (r < I_PG) { transpose_item(w_ple_gate, 1024, 1024, WPG, 0, scr, r, lane); continue; } r -= I_PG;
            transpose_item(w_ple_proj, 256, 1024, WPP, 0, scr, r, lane);
        }
        for (int i = gt; i < 96 * 1024 / 8; i += NGT) *(v4u*)(WIN + (size_t)672 * 1024 + (size_t)i * 8) = (v4u){0u, 0u, 0u, 0u};
        for (int m = gw; m < NTOK; m += 4 * NGW) rms_rows_to_bf16<4>(x, g_mix, XN, m, NGW, lane);
        for (int i = gt; i < NTOK * PLE / 8; i += NGT) { const f32x4 a = __builtin_nontemporal_load((const f32x4*)(pin + (size_t)i * 8)), b = __builtin_nontemporal_load((const f32x4*)(pin + (size_t)i * 8 + 4));
            v4u o; o.x = pk2(a.x, a.y); o.y = pk2(a.z, a.w); o.z = pk2(b.x, b.y); o.w = pk2(b.z, b.w); *(v4u*)(PB + (size_t)i * 8) = o; }
        for (int i = gt; i < NTOK * 16; i += NGT) { const int m = i >> 4, j = i & 15; const float ang = (float)positions[m] * inv_freq(j);
            const double rev = (double)ang * 0.15915494309189535; const float fr = (float)(rev - __builtin_floor(rev));
            COS[i] = __builtin_amdgcn_cosf(fr); SIN[i] = __builtin_amdgcn_sinf(fr); }
    }
    if (__builtin_expect(args.ws == nullptr, 0)) CG_SYNC();
    GRID_SYNC();

    NEWPHASE();
    { pg8::Gemm g{XN, WIN, NTOK, DINP, DM}; pg8::StaticOrder S; S.init(NTOK, DINP, G, bx);
      pg8::Epi<pg8::M_PROJ> E{PROJ, DINP, nullptr, 0, nullptr, nullptr, 1.f, (float*)ws, 0, 0.f};
      pg8::gemm_phase<pg8::Epi<pg8::M_PROJ>, pg8::StaticOrder, true, true>(lds, g, S, E); }
    GRID_SYNC();


    NEWPHASE();
    { pg8::Gemm g{PROJ + C_CQ, WQB, NTOK, 768, QRANK, DINP}; pg8::StaticOrder S; S.init(NTOK, 768, G, bx);
      pg8::Epi<pg8::M_SCALER> E{Qb, 768, nullptr, 0, nullptr, nullptr, MLA_C2, SSQ, 12, 1.f / QRANK};
      pg8::gemm_phase<pg8::Epi<pg8::M_SCALER>, pg8::StaticOrder, true, true>(lds, g, S, E); }
    { pg8::Gemm g{PROJ + C_CKV, WKVB, NTOK, 1024, KVRANK, DINP}; pg8::StaticOrder S; S.init(NTOK, 1024, G, bx);
      pg8::Epi<pg8::M_SCALER> E{KVb, 1024, nullptr, 0, nullptr, nullptr, 1.f, SSKV, 8, 1.f / KVRANK};
      pg8::gemm_phase<pg8::Epi<pg8::M_SCALER>, pg8::StaticOrder, true, true>(lds, g, S, E); }
    GRID_SYNC();

    NEWPHASE();
    for (int i = 0;; ++i) { const int idx = i * G + vcu; if (idx >= 1024) break;
        const int rnd = idx >> 8, v = idx & 255, bh = v >> 2, s = v & 3; const int qb = (rnd == 0) ? 15 - s : (rnd == 1) ? 8 + s : (rnd == 2) ? 7 - s : s;
        att::mla_unit(bh >> 3, bh & 7, qb, Qb, KVb, KPE, COS, SIN, OA, (att::lptr)lds); }
    for (int i = 0;; ++i) { const int idx = i * G + vcu; if (idx >= 1024) break;
        const int rnd = idx >> 8, v = idx & 255, bh = v >> 2, s = v & 3; const int qb = (rnd == 0) ? 15 - s : (rnd == 1) ? 8 + s : (rnd == 2) ? 7 - s : s;
        att::sb_unit(bh >> 3, bh & 7, qb, PROJ, OA, (att::lptr)lds); }
    GRID_SYNC();

    NEWPHASE();
    { pg8::Gemm g{OA, WBRA, NTOK, 1024, 512, 1024, 1024}; pg8::SplitOrder S; S.base.init(NTOK, 1024, G, bx);
      pg8::Epi<pg8::M_GATEF> E{MERGED, 1024, PROJ + C_GA, DINP, nullptr, nullptr, 1.f, nullptr, 0, 0.f};
      pg8::gemm_phase<pg8::Epi<pg8::M_GATEF>, pg8::SplitOrder, true, true>(lds, g, S, E); }
    GRID_SYNC();

    NEWPHASE();
    { pg8::Gemm g{MERGED, WOUT, NTOK, 1024, 1024}; pg8::StaticOrder S; S.init(NTOK, 1024, G, bx);
      pg8::Epi<pg8::M_RES> E{H1B, 1024, nullptr, 0, x, nullptr, 1.f, nullptr, 0, 0.f};
      pg8::gemm_phase<pg8::Epi<pg8::M_RES>, pg8::StaticOrder, true, true>(lds, g, S, E); }
    GRID_SYNC();

    NEWPHASE();
    { int tid7 = threadIdx.x; asm volatile("" : "+v"(tid7)); const int lane7 = tid7 & 63;
      for (int m = gw; m < NTOK; m += 4 * NGW) rms_rows_bf16_to_bf16<4>(H1B, g_ffn, XN, m, NGW, lane7); }
    GRID_SYNC();

    NEWPHASE();
    { pg8::Gemm g{XN, WGU, NTOK, 2 * DFF, DM}; pg8::StaticOrder S; S.init(NTOK, 2 * DFF, G, bx);
      pg8::Epi<pg8::M_SWIGLU> E{ACT, DFF, nullptr, 0, nullptr, nullptr, 1.f, nullptr, 0, 0.f};
      pg8::gemm_phase<pg8::Epi<pg8::M_SWIGLU>, pg8::StaticOrder, true, true>(lds, g, S, E); }
    GRID_SYNC();

    NEWPHASE();
    { pg8::Gemm g{ACT, WDN, NTOK, 1024, DFF}; pg8::StaticOrder S; S.init(NTOK, 1024, G, bx);
      pg8::Epi<pg8::M_RES2> E{H2B, 1024, H1B, 1024, nullptr, nullptr, 1.f, nullptr, 0, 0.f};
      pg8::gemm_phase<pg8::Epi<pg8::M_RES2>, pg8::StaticOrder, true, true>(lds, g, S, E); }
    GRID_SYNC();

    NEWPHASE();
    { pg8::Gemm g{PB, WPP, NTOK, 1024, PLE}; pg8::StaticOrder S; S.init(NTOK, 1024, G, bx);
      pg8::Epi<pg8::M_SCALE> E{EP, 1024, nullptr, 0, nullptr, nullptr, 1.f, nullptr, 0, 0.f};
      pg8::gemm_phase<pg8::Epi<pg8::M_SCALE>, pg8::StaticOrder, false, true>(lds, g, S, E); }
    { pg8::Gemm g{H2B, WPG, NTOK, 1024, 1024}; pg8::StaticOrder S; S.init(NTOK, 1024, G, bx);
      pg8::Epi<pg8::M_SIG> E{GS, 1024, nullptr, 0, nullptr, nullptr, 1.f, nullptr, 0, 0.f};
      pg8::gemm_phase<pg8::Epi<pg8::M_SIG>, pg8::StaticOrder, true, true>(lds, g, S, E); }
    GRID_SYNC();

    NEWPHASE();
    int tid11 = threadIdx.x; asm volatile("" : "+v"(tid11)); const int lane11 = tid11 & 63;
    for (int m0 = gw; m0 < NTOK; m0 += 2 * NGW) {
        f32x4 v[2][4], e[2][4], gsv[2][4]; float se[2], s3[2];
#pragma unroll
        for (int r = 0; r < 2; ++r) { const size_t m = (size_t)(m0 + r * NGW);
            const v2u* hr = (const v2u*)(H2B + m * DM) + lane11; const v2u* er = (const v2u*)(EP + m * DM) + lane11; const v2u* sr = (const v2u*)(GS + m * DM) + lane11;
#pragma unroll
            for (int j = 0; j < 4; ++j) { const v2u wh = __builtin_nontemporal_load(hr + 64 * j); v[r][j] = (f32x4){pg8::bf_lo(wh.x), pg8::bf_hi(wh.x), pg8::bf_lo(wh.y), pg8::bf_hi(wh.y)}; const v2u w = __builtin_nontemporal_load(er + 64 * j); const v2u w2 = __builtin_nontemporal_load(sr + 64 * j);
                e[r][j] = (f32x4){pg8::bf_lo(w.x), pg8::bf_hi(w.x), pg8::bf_lo(w.y), pg8::bf_hi(w.y)}; gsv[r][j] = (f32x4){pg8::bf_lo(w2.x), pg8::bf_hi(w2.x), pg8::bf_lo(w2.y), pg8::bf_hi(w2.y)}; } }
        f32x4 gp4[4], gf4[4];
#pragma unroll
        for (int j = 0; j < 4; ++j) { gp4[j] = ((const f32x4*)g_ple + lane11)[64 * j]; gf4[j] = ((const f32x4*)g_final + lane11)[64 * j]; }
#pragma unroll
        for (int r = 0; r < 2; ++r) { se[r] = 0.f;
#pragma unroll
            for (int j = 0; j < 4; ++j) se[r] += (e[r][j].x * e[r][j].x + e[r][j].y * e[r][j].y) + (e[r][j].z * e[r][j].z + e[r][j].w * e[r][j].w); }
#pragma unroll
        for (int o = 1; o < 64; o <<= 1) { se[0] += __shfl_xor(se[0], o); se[1] += __shfl_xor(se[1], o); }
#pragma unroll
        for (int r = 0; r < 2; ++r) { const float rse = 1.0f / sqrtf(se[r] * (1.f / DM) + EPS); s3[r] = 0.f;
#pragma unroll
            for (int j = 0; j < 4; ++j) { v[r][j] = v[r][j] + gsv[r][j] * (e[r][j] * rse * gp4[j]); s3[r] += (v[r][j].x * v[r][j].x + v[r][j].y * v[r][j].y) + (v[r][j].z * v[r][j].z + v[r][j].w * v[r][j].w); } }
#pragma unroll
        for (int o = 1; o < 64; o <<= 1) { s3[0] += __shfl_xor(s3[0], o); s3[1] += __shfl_xor(s3[1], o); }
#pragma unroll
        for (int r = 0; r < 2; ++r) { const float rs3 = 1.0f / sqrtf(s3[r] * (1.f / DM) + EPS); f32x4* hw = (f32x4*)(H + (size_t)(m0 + r * NGW) * DM) + lane11;
#pragma unroll
            for (int j = 0; j < 4; ++j) __builtin_nontemporal_store(v[r][j] * rs3 * gf4[j], hw + 64 * j); }
    }
}

#undef WIN
#undef WQB
#undef WKVB
#undef WBRA
#undef WBRB
#undef WOUT
#undef WGU
#undef WDN
#undef WPG
#undef WPP
#undef SSQ
#undef SSKV
#undef COS
#undef SIN
#undef KPE
#undef PB
#undef XN
#undef CQN
#undef CKVN
#undef OA
#undef OB
#undef PROJ
#undef ACT
#undef EP
#undef GS
#undef H1B
#undef Qb
#undef KVb
#undef MERGED
#undef H2B
#undef NEWPHASE
extern "C" void kernel_launch(void* const* d_in, const int* in_sizes, int n_in, void* d_out, int out_size, void* d_ws, size_t ws_size, hipStream_t stream) {
    static int grid = 0;
    if (grid == 0) {
        if (n_in != 20 || out_size != NTOK * DM || ws_size < WS_END) { fprintf(stderr, "kernel_launch: unexpected shapes (n_in %d out %d ws %zu)\n", n_in, out_size, ws_size); grid = -1; return; }
        int dev = 0, cus = 0, per_cu = 0;
        if (hipGetDevice(&dev) != hipSuccess || hipDeviceGetAttribute(&cus, hipDeviceAttributeMultiprocessorCount, dev) != hipSuccess) { grid = -1; return; }
        if (hipFuncSetAttribute((const void*)fwd_megakernel, hipFuncAttributeMaxDynamicSharedMemorySize, LDS_BYTES) != hipSuccess) { fprintf(stderr, "kernel_launch: hipFuncSetAttribute failed\n"); grid = -1; return; }
        if (hipOccupancyMaxActiveBlocksPerMultiprocessor(&per_cu, (const void*)fwd_megakernel, NWAVES * 64, LDS_BYTES) != hipSuccess || per_cu < 1) { fprintf(stderr, "kernel_launch: occupancy query says %d\n", per_cu); per_cu = 1; }
        (void)hipGetLastError();
        grid = cus;
    }
    if (grid < 0) return;
    if (hipMemsetAsync(d_ws, 0, 65536, stream) != hipSuccess) { fprintf(stderr, "kernel_launch: memset failed\n"); return; }
    Args a{};
    for (int i = 0; i < 20; ++i) a.in[i] = d_in[i];
    a.out = (float*)d_out; a.ws = (unsigned char*)d_ws;
    void* kargs[] = {&a};
    hipError_t e = hipLaunchCooperativeKernel((const void*)fwd_megakernel, dim3(grid), dim3(NWAVES * 64), kargs, LDS_BYTES, stream);
    if (e != hipSuccess) fprintf(stderr, "kernel_launch: cooperative launch failed: %s (grid %d)\n", hipGetErrorString(e), grid);
}
```

```cpp
#include <hip/hip_runtime.h>
#include <hip/hip_cooperative_groups.h>
#include <cstdio>
#include <cstdint>
namespace cg = cooperative_groups;

constexpr int NB = 8, SEQ = 4096, DM = 1024, NTOK = NB * SEQ;
constexpr int PLE = 256, QRANK = 384, KVRANK = 256, ROPE = 32, NH = 8;
constexpr int DFF = 2816, DINP = 4352;
constexpr int C_CQ = 0, C_CKV = 384, C_KPE = 640, C_QSB = 768, C_KSB = 1280, C_VSB = 1792, C_GA = 2304, C_GB = 3328;
constexpr float EPS = 1e-6f;
constexpr float LOG2E = 1.4426950408889634f;
constexpr float MLA_C2 = 0.10206207261596575f * 1.4426950408889634f;

namespace pg8 {
#define PG8_LAS __attribute__((address_space(3)))
typedef unsigned short bf16_t;
typedef short bf16x8 __attribute__((ext_vector_type(8)));
typedef float f32x4 __attribute__((ext_vector_type(4)));
typedef unsigned u32x4 __attribute__((ext_vector_type(4)));
constexpr int BM = 256, BK = 64, HALF = 128, HTB = HALF * BK * 2  , STAGE_BYTES = 8 * HTB, NXCD = 8, WGM = 8;

__host__ __device__ __forceinline__ int lds_byte(int r, int c) { const int st = (r >> 4) * 2 + (c >> 5), rr = r & 15, cc = c & 31, ob = rr * 64 + cc * 2; return st * 1024 + (ob ^ (((ob >> 9) & 1) << 5)); }
__host__ __device__ __forceinline__ void stage_rc(int b, int& R, int& C) { const int st = b / 1024, sb = b % 1024, swz = sb ^ (((sb >> 9) & 1) << 5); R = (st >> 1) * 16 + swz / 64; C = (st & 1) * 32 + (swz % 64) / 2; }
__host__ __device__ __forceinline__ int perm32(int rho) { const int n = rho >> 4, i = rho & 15; return 8 * (i >> 2) + 4 * n + (i & 3); }

struct Unit { int pm, pn, kh; };
struct Gemm { const bf16_t* A; const bf16_t* Bt; int M, N, K; int lda; int ldb; };

struct StaticOrder {
    int nM, nN, nwg, G, c;
    __host__ __device__ void init(int M, int N, int G_, int c_) { nM = M / BM; nN = N / BM; nwg = nM * nN; G = G_; c = c_; }
    __host__ __device__ bool next(int i, Unit& u) const {
        const long L = (long)i * G + c; if (L >= nwg) return false;
        int wgid = (int)L; { const int q = nwg / NXCD, r = nwg % NXCD, xcd = wgid % NXCD, off = wgid / NXCD; wgid = (xcd < r ? xcd * (q + 1) : r * (q + 1) + (xcd - r) * q) + off; }
        const int nig = WGM * nN, gid = wgid / nig, fm = gid * WGM, gsz = (nM - fm) < WGM ? (nM - fm) : WGM;
        u.pm = fm + ((wgid % nig) % gsz); u.pn = (wgid % nig) / gsz; return true;
    }
    __device__ __forceinline__ void a_ready(const Unit&) const {}
    __device__ __forceinline__ void done(const Unit&) const {}
};

typedef float f32x2_c __attribute__((ext_vector_type(2))); typedef __bf16 bf16x2_c __attribute__((ext_vector_type(2)));
__device__ __forceinline__ unsigned cvt_pk_bf16(float lo, float hi) { f32x2_c v = {lo, hi}; bf16x2_c b = __builtin_convertvector(v, bf16x2_c); return __builtin_bit_cast(unsigned, b); }
__device__ __forceinline__ float bf_lo(unsigned w) { return __uint_as_float(w << 16); }
__device__ __forceinline__ float bf_hi(unsigned w) { return __uint_as_float(w & 0xffff0000u); }
__device__ __forceinline__ float sigmoidf_fast(float v) { return __builtin_amdgcn_rcpf(1.0f + __builtin_amdgcn_exp2f(-v * 1.4426950408889634f)); }
__device__ __forceinline__ u32x4 pack8(const f32x4& a, const f32x4& b) { u32x4 w; w.x = cvt_pk_bf16(a[0], a[1]); w.y = cvt_pk_bf16(a[2], a[3]); w.z = cvt_pk_bf16(b[0], b[1]); w.w = cvt_pk_bf16(b[2], b[3]); return w; }
__device__ __forceinline__ void unpack8(const u32x4& w, f32x4& a, f32x4& b) { a = (f32x4){bf_lo(w.x), bf_hi(w.x), bf_lo(w.y), bf_hi(w.y)}; b = (f32x4){bf_lo(w.z), bf_hi(w.z), bf_lo(w.w), bf_hi(w.w)}; }

enum EpiMode { M_GATEF = 9, M_SCALER = 8, M_PROJ = 0, M_SCALE = 1, M_SIG = 2, M_GATE1 = 3, M_GATE2 = 4, M_RES = 5, M_RES2 = 6, M_SWIGLU = 7 };
template <int MODE> struct Epi {
    static constexpr bool PERM = true, AFTER_DRAIN = false, HAS_MID = (MODE == M_GATEF);
    __device__ __forceinline__ void mid(f32x4 (&acc)[2][2][4][2], const Unit& u, int wr, int wc, int fr, int fq) const {
        const unsigned lane_off = (unsigned)(((wr * 64 + fr) * ldg + wc * 32 + 8 * fq) * 2);
#pragma unroll
        for (int ai = 0; ai < 2; ++ai)
#pragma unroll
            for (int m = 0; m < 4; ++m) {
#pragma unroll
                for (int bj = 0; bj < 2; ++bj) { const size_t uni = ((size_t)(u.pm * BM + ai * HALF + m * 16) * ldg + 256 * (2 * u.pn + bj)) * 2;
                    f32x4 a, b; unpack8(*(const u32x4*)((const char*)G + uni + lane_off), a, b);
                    acc[ai][bj][m][0] = acc[ai][bj][m][0] * a; acc[ai][bj][m][1] = acc[ai][bj][m][1] * b; }
                asm volatile("" ::: "memory"); }
    }
    bf16_t* O; int ldo;
    const bf16_t* G; int ldg;
    const float* X; float* H;
    float scale;
    float* SQ;
    int np; float inv_n;
    __device__ __forceinline__ void operator()(const f32x4 (&acc)[2][2][4][2], const Unit& u, int wr, int wc, int fr, int fq) const {
        const int row0 = u.pm * BM + wr * 64 + fr;
#pragma unroll
        for (int ai = 0; ai < 2; ++ai)
#pragma unroll
            for (int m = 0; m < 4; ++m) {
                const size_t row = (size_t)(row0 + ai * HALF + m * 16);
                if constexpr (MODE == M_SWIGLU) {
                    const int col = u.pn * HALF + wc * 32 + 8 * fq;
                    f32x4 g0 = acc[ai][0][m][0], g1 = acc[ai][0][m][1]; const f32x4 u0 = acc[ai][1][m][0], u1 = acc[ai][1][m][1];
#pragma unroll
                    for (int i = 0; i < 4; ++i) { g0[i] = g0[i] * sigmoidf_fast(g0[i]) * u0[i]; g1[i] = g1[i] * sigmoidf_fast(g1[i]) * u1[i]; }
                    *(u32x4*)(O + row * ldo + col) = pack8(g0, g1);
                } else {
                    float rsc = scale;
                    if constexpr (MODE == M_SCALER) { float t = 0.f;
#pragma unroll
                        for (int k = 0; k < 3; ++k) if (4 * k < np) { const f32x4 pz = *(const f32x4*)(SQ + row * np + 4 * k); t += (pz[0] + pz[1]) + (pz[2] + pz[3]); }
                        rsc = scale / sqrtf(t * inv_n + 1e-6f); }
#pragma unroll
                    for (int bj = 0; bj < 2; ++bj) {
                        const int col = u.pn * BM + bj * HALF + wc * 32 + 8 * fq;
                        f32x4 v0 = acc[ai][bj][m][0], v1 = acc[ai][bj][m][1];
                        if constexpr (MODE == M_PROJ) {
                            if (u.pn <= 2) { unsigned char* wsb = (unsigned char*)SQ; float* SQq = (float*)(wsb + 37u * 1048576u); float* SKV = (float*)(wsb + 46u * 1048576u);
                                const float* CS = (const float*)(wsb + 40u * 1048576u); const float* SN = (const float*)(wsb + 42u * 1048576u); bf16_t* KP = (bf16_t*)(wsb + 44u * 1048576u);
                                if (!(u.pn == 2 && bj == 1)) {
                                    float q = (v0[0] * v0[0] + v0[1] * v0[1]) + (v0[2] * v0[2] + v0[3] * v0[3]) + (v1[0] * v1[0] + v1[1] * v1[1]) + (v1[2] * v1[2] + v1[3] * v1[3]);
                                    q += __shfl_xor(q, 16); q += __shfl_xor(q, 32);
                                    if (fq == 0) { if (u.pn == 0) SQq[row * 12 + bj * 4 + wc] = q; else if (u.pn == 1 && bj == 0) SQq[row * 12 + 8 + wc] = q; else if (u.pn == 1) SKV[row * 8 + wc] = q; else SKV[row * 8 + 4 + wc] = q; }
                                } else if (wc == 0) {
                                    const int j0 = 8 * (fq & 1); f32x4 r0, r1;
                                    { const f32x4 c = *(const f32x4*)(CS + row * 16 + j0), sn = *(const f32x4*)(SN + row * 16 + j0);
#pragma unroll
                                      for (int i = 0; i < 4; ++i) { const float xp = __shfl_xor(v0[i], 32); r0[i] = fq < 2 ? v0[i] * c[i] - xp * sn[i] : xp * sn[i] + v0[i] * c[i]; } }
                                    { const f32x4 c = *(const f32x4*)(CS + row * 16 + j0 + 4), sn = *(const f32x4*)(SN + row * 16 + j0 + 4);
#pragma unroll
                                      for (int i = 0; i < 4; ++i) { const float xp = __shfl_xor(v1[i], 32); r1[i] = fq < 2 ? v1[i] * c[i] - xp * sn[i] : xp * sn[i] + v1[i] * c[i]; } }
                                    *(u32x4*)(KP + row * 32 + 8 * fq) = pack8(r0, r1);
                                }
                            }
                            if (u.pn >= 9) {
                                if (bj == 0) { f32x4 a0 = acc[ai][0][m][0], a1 = acc[ai][0][m][1], b0 = acc[ai][1][m][0], b1 = acc[ai][1][m][1];
#pragma unroll
                                    for (int i = 0; i < 4; ++i) { const float sb0 = __builtin_fmaxf(sigmoidf_fast(b0[i]), 1e-30f), sb1 = __builtin_fmaxf(sigmoidf_fast(b1[i]), 1e-30f);
                                        a0[i] = sigmoidf_fast(a0[i]) * __builtin_amdgcn_rcpf(sb0); a1[i] = sigmoidf_fast(a1[i]) * __builtin_amdgcn_rcpf(sb1); b0[i] = sb0; b1[i] = sb1; }
                                    *(u32x4*)(O + row * ldo + col) = pack8(a0, a1); *(u32x4*)(O + row * ldo + col + HALF) = pack8(b0, b1); }
                            } else { if (u.pn == 3 || u.pn == 4) { v0 = v0 * (0.125f * 1.4426950408889634f); v1 = v1 * (0.125f * 1.4426950408889634f); }
                                *(u32x4*)(O + row * ldo + col) = pack8(v0, v1); }
                        } else if constexpr (MODE == M_GATEF) {
                            const unsigned lane_off = (unsigned)(((wr * 64 + fr) * ldg + wc * 32 + 8 * fq) * 2);
                            const size_t uni = ((size_t)(u.pm * BM + ai * HALF + m * 16) * ldg + 256 * (2 * u.pn + bj) + HALF) * 2;
                            f32x4 a, b; unpack8(*(const u32x4*)((const char*)G + uni + lane_off), a, b);
                            *(u32x4*)(O + row * ldo + col) = pack8(v0 * a, v1 * b);
                        } else if constexpr (MODE == M_SCALER) {
                            v0 = v0 * rsc; v1 = v1 * rsc;
                            *(u32x4*)(O + row * ldo + col) = pack8(v0, v1);
                        } else if constexpr (MODE == M_SCALE) {
                            v0 = v0 * scale; v1 = v1 * scale;
                            *(u32x4*)(O + row * ldo + col) = pack8(v0, v1);
                        } else if constexpr (MODE == M_SIG) {
#pragma unroll
                            for (int i = 0; i < 4; ++i) { v0[i] = sigmoidf_fast(v0[i]); v1[i] = sigmoidf_fast(v1[i]); }
                            *(u32x4*)(O + row * ldo + col) = pack8(v0, v1);
                        } else if constexpr (MODE == M_GATE1) {
                            f32x4 a, b; unpack8(*(const u32x4*)(G + row * ldg + col), a, b);
                            v0 = v0 * a; v1 = v1 * b;
                            *(u32x4*)(O + row * ldo + col) = pack8(v0, v1);
                        } else if constexpr (MODE == M_GATE2) {
                            f32x4 a, b, c, d; unpack8(*(const u32x4*)(G + row * ldg + col), a, b); unpack8(*(const u32x4*)(O + row * ldo + col), c, d);
                            v0 = c + v0 * a; v1 = d + v1 * b;
                            *(u32x4*)(O + row * ldo + col) = pack8(v0, v1);
                        } else if constexpr (MODE == M_RES) {
                            const f32x4 x0 = *(const f32x4*)(X + row * DM + col), x1 = *(const f32x4*)(X + row * DM + col + 4);
                            v0 = x0 + v0; v1 = x1 + v1;
                            *(u32x4*)(O + row * ldo + col) = pack8(v0, v1);
                        } else if constexpr (MODE == M_RES2) {
                            f32x4 x0, x1; unpack8(*(const u32x4*)(G + row * ldg + col), x0, x1);
                            v0 = x0 + v0; v1 = x1 + v1;
                            *(u32x4*)(O + row * ldo + col) = pack8(v0, v1);
                        }
                    }
                }
                if (m & 1) asm volatile("" ::: "memory");
            }
    }
};

struct SplitOrder {
    StaticOrder base;
    __device__ bool next(int i, Unit& u) const { const bool ok = base.next(i >> 1, u); u.kh = i & 1; return ok; }
    __device__ __forceinline__ void a_ready(const Unit&) const {}
    __device__ __forceinline__ void done(const Unit&) const {}
};

template <class Epi, class Sched, bool ALIGN_EPI = false, bool SP2 = false>
__device__ __forceinline__ void gemm_phase(PG8_LAS unsigned char* lds, const Gemm g, const Sched& S, const Epi& E) {
    int tid_ = threadIdx.x; asm volatile("" : "+v"(tid_));
    const int tid = tid_, wid = __builtin_amdgcn_readfirstlane(tid >> 6), lane = tid & 63, wr = wid >> 2, wc = wid & 3, fr = lane & 15, fq = lane >> 4;
    const int K = g.K, nt = K / BK, lda = g.lda ? g.lda : g.K, ldb = g.ldb ? g.ldb : g.K;
    unsigned voffA[2], voffB[2];
#pragma unroll
    for (int i = 0; i < 2; ++i) { int R, C; stage_rc(tid * 16 + i * 8192, R, C); const int Rb = Epi::PERM ? ((R & ~31) + perm32(R & 31)) : R;
        voffA[i] = (unsigned)(R * lda + C) * 2u; voffB[i] = (unsigned)(Rb * ldb + C) * 2u; }
    const size_t kstep = (size_t)(BK * 2);
    const size_t hstep = (size_t)HALF * ldb * 2;
    const size_t tstep = 2 * hstep;
    const size_t hstepA = (size_t)HALF * lda * 2, tstepA = 2 * hstepA;
    const unsigned ldsw = (unsigned)wid * 1024u;
    const int aoff = lds_byte(wr * 64 + fr, fq * 8), boff = lds_byte(wc * 32 + fr, fq * 8);
#define PG8_SA(b, h) (((b) * 2 + (h)) * HTB)
#define PG8_SB(b, h) ((4 + (b) * 2 + (h)) * HTB)
#define PG8_STAGE(bufoff, gbase, voff) do { _Pragma("unroll") for (int _i = 0; _i < 2; ++_i) \
        __builtin_amdgcn_global_load_lds((const unsigned*)((const char*)(gbase) + (voff)[_i]), (PG8_LAS unsigned*)(lds + (bufoff) + ldsw + _i * 8192), 16, 0, 0); } while (0)
#define PG8_LDA(dst, b, h) do { _Pragma("unroll") for (int m = 0; m < 4; ++m) _Pragma("unroll") for (int k = 0; k < 2; ++k) dst[m][k] = *(const PG8_LAS bf16x8*)(lds + PG8_SA(b, h) + aoff + m * 2048 + k * 1024); } while (0)
#define PG8_LDB(dst, b, h) do { _Pragma("unroll") for (int n = 0; n < 2; ++n) _Pragma("unroll") for (int k = 0; k < 2; ++k) dst[n][k] = *(const PG8_LAS bf16x8*)(lds + PG8_SB(b, h) + boff + n * 2048 + k * 1024); } while (0)
#define PG8_MMA(ai, bj, At, Bt) do { __builtin_amdgcn_s_setprio(1); _Pragma("unroll") for (int m = 0; m < 4; ++m) _Pragma("unroll") for (int n = 0; n < 2; ++n) _Pragma("unroll") for (int k = 0; k < 2; ++k) \
        acc[ai][bj][m][n] = __builtin_amdgcn_mfma_f32_16x16x32_bf16(Bt[n][k], At[m][k], acc[ai][bj][m][n], 0, 0, 0); __builtin_amdgcn_s_setprio(0); } while (0)
#define PG8_WAIT_V(n) asm volatile("s_waitcnt vmcnt(" #n ")" ::: "memory")
#define PG8_WAIT_L(n) asm volatile("s_waitcnt lgkmcnt(" #n ")" ::: "memory")
#define PG8_BAR __builtin_amdgcn_s_barrier()
#define PG8_SCHED __builtin_amdgcn_sched_barrier(0)
    Unit cur, nxt; int ui = 0;
    if (!S.next(0, cur)) return;
    f32x4 acc[2][2][4][2];
    bf16x8 At[4][2], B0[2][2], B1[2][2];
    const size_t khb = Epi::HAS_MID ? (size_t)K * 2 : 0;
    const char* cA = (const char*)g.A + (size_t)cur.pm * tstepA + (Epi::HAS_MID ? cur.kh * khb : 0); const char* cB = (const char*)g.Bt + (size_t)cur.pn * tstep + (Epi::HAS_MID ? cur.kh * khb : 0);
    S.a_ready(cur);
    if constexpr (SP2) {
        PG8_STAGE(PG8_SB(0, 0), cB, voffB); PG8_STAGE(PG8_SB(0, 1), cB + hstep, voffB); PG8_STAGE(PG8_SA(0, 0), cA, voffA); PG8_STAGE(PG8_SA(0, 1), cA + hstepA, voffA);
        if (wr == 1) PG8_BAR;
        PG8_WAIT_V(2); PG8_BAR;
        PG8_STAGE(PG8_SB(1, 0), cB + kstep, voffB); PG8_STAGE(PG8_SA(1, 0), cA + kstep, voffA); PG8_STAGE(PG8_SB(1, 1), cB + hstep + kstep, voffB);
        PG8_WAIT_V(6); PG8_BAR;
    } else {
        PG8_STAGE(PG8_SB(0, 0), cB, voffB); PG8_STAGE(PG8_SA(0, 0), cA, voffA); PG8_STAGE(PG8_SB(0, 1), cB + hstep, voffB); PG8_STAGE(PG8_SA(0, 1), cA + hstepA, voffA);
        if (wr == 1) PG8_BAR;
        PG8_WAIT_V(4); PG8_BAR;
        PG8_STAGE(PG8_SB(1, 0), cB + kstep, voffB); PG8_STAGE(PG8_SA(1, 0), cA + kstep, voffA); PG8_STAGE(PG8_SB(1, 1), cB + hstep + kstep, voffB);
        PG8_WAIT_V(6); PG8_BAR;
    }
#pragma unroll
    for (int a = 0; a < 2; ++a)
#pragma unroll
        for (int b = 0; b < 2; ++b)
#pragma unroll
            for (int m = 0; m < 4; ++m)
#pragma unroll
                for (int n = 0; n < 2; ++n) acc[a][b][m][n] = (f32x4){0.f, 0.f, 0.f, 0.f};
    for (;;) {
        const bool has_next = S.next(ui + 1, nxt);
        const char* nA = has_next ? (const char*)g.A + (size_t)nxt.pm * tstepA + (Epi::HAS_MID ? nxt.kh * khb : 0) : cA; const char* nB = has_next ? (const char*)g.Bt + (size_t)nxt.pn * tstep + (Epi::HAS_MID ? nxt.kh * khb : 0) : cB;
        for (int t = 0; t < nt; t += 2) {
            const bool last = (t == nt - 2);
            const char* a1 = cA + (size_t)(t + 1) * kstep;
            const char* a2 = last ? nA : cA + (size_t)(t + 2) * kstep; const char* b2 = last ? nB : cB + (size_t)(t + 2) * kstep;
            const char* a3 = a2 + kstep; const char* b3 = b2 + kstep;
            if (last && has_next) S.a_ready(nxt);
            if constexpr (SP2) {
            PG8_LDB(B0, 0, 0); PG8_LDB(B1, 0, 1); PG8_SCHED; PG8_LDA(At, 0, 0); PG8_STAGE(PG8_SA(1, 1), a1 + hstepA, voffA);
            PG8_WAIT_V(8); PG8_WAIT_L(0); PG8_BAR; PG8_MMA(0, 0, At, B0); PG8_MMA(0, 1, At, B1); PG8_BAR; PG8_SCHED;
            PG8_LDA(At, 0, 1); PG8_STAGE(PG8_SB(0, 0), b2, voffB); PG8_STAGE(PG8_SB(0, 1), b2 + hstep, voffB); PG8_STAGE(PG8_SA(0, 0), a2, voffA);
            PG8_WAIT_V(8); PG8_WAIT_L(0); PG8_BAR; PG8_MMA(1, 0, At, B0); PG8_MMA(1, 1, At, B1); PG8_BAR; PG8_SCHED;
            PG8_LDB(B0, 1, 0); PG8_LDB(B1, 1, 1); PG8_SCHED; PG8_LDA(At, 1, 0); PG8_STAGE(PG8_SA(0, 1), a2 + hstepA, voffA);
            PG8_WAIT_V(8); PG8_WAIT_L(0); PG8_BAR; PG8_MMA(0, 0, At, B0); PG8_MMA(0, 1, At, B1); PG8_BAR; PG8_SCHED;
            PG8_LDA(At, 1, 1); PG8_STAGE(PG8_SB(1, 0), b3, voffB); PG8_STAGE(PG8_SB(1, 1), b3 + hstep, voffB); PG8_STAGE(PG8_SA(1, 0), a3, voffA);
            PG8_WAIT_V(8); PG8_WAIT_L(0); PG8_BAR; PG8_MMA(1, 0, At, B0); PG8_MMA(1, 1, At, B1); PG8_BAR; PG8_SCHED;
            } else {
            PG8_LDB(B0, 0, 0); PG8_SCHED; PG8_LDA(At, 0, 0); PG8_STAGE(PG8_SA(1, 1), a1 + hstepA, voffA);
            PG8_WAIT_L(8); PG8_BAR; PG8_WAIT_L(0); PG8_MMA(0, 0, At, B0); PG8_BAR; PG8_SCHED;
            PG8_LDB(B1, 0, 1); PG8_STAGE(PG8_SB(0, 0), b2, voffB);
            PG8_BAR; PG8_WAIT_L(0); PG8_MMA(0, 1, At, B1); PG8_BAR;
            PG8_LDA(At, 0, 1); PG8_STAGE(PG8_SA(0, 0), a2, voffA);
            PG8_BAR; PG8_WAIT_L(0); PG8_MMA(1, 0, At, B0); PG8_BAR; PG8_SCHED;
            PG8_STAGE(PG8_SB(0, 1), b2 + hstep, voffB);
            PG8_WAIT_V(6); PG8_BAR; PG8_MMA(1, 1, At, B1); PG8_BAR;
            PG8_LDB(B0, 1, 0); PG8_SCHED; PG8_LDA(At, 1, 0); PG8_STAGE(PG8_SA(0, 1), a2 + hstepA, voffA);
            PG8_WAIT_L(8); PG8_BAR; PG8_WAIT_L(0); PG8_MMA(0, 0, At, B0); PG8_BAR; PG8_SCHED;
            PG8_LDB(B1, 1, 1); PG8_STAGE(PG8_SB(1, 0), b3, voffB);
            PG8_BAR; PG8_WAIT_L(0); PG8_MMA(0, 1, At, B1); PG8_BAR;
            PG8_LDA(At, 1, 1); PG8_STAGE(PG8_SA(1, 0), a3, voffA);
            PG8_BAR; PG8_WAIT_L(0); PG8_MMA(1, 0, At, B0); PG8_BAR; PG8_SCHED;
            PG8_STAGE(PG8_SB(1, 1), b3 + hstep, voffB);
            PG8_WAIT_V(6); PG8_BAR; PG8_MMA(1, 1, At, B1); PG8_BAR;
            }
        }
        if constexpr (ALIGN_EPI) { if (wr == 0) PG8_BAR; }
        bool keep_acc = false;
        if constexpr (!Epi::AFTER_DRAIN) {
            if constexpr (Epi::HAS_MID) { if (cur.kh == 0) { E.mid(acc, cur, wr, wc, fr, fq); keep_acc = true; } else E(acc, cur, wr, wc, fr, fq); }
            else E(acc, cur, wr, wc, fr, fq);
            S.done(cur); }
        if (!has_next) break;
        if (!keep_acc)
#pragma unroll
        for (int a = 0; a < 2; ++a)
#pragma unroll
            for (int b = 0; b < 2; ++b)
#pragma unroll
                for (int m = 0; m < 4; ++m)
#pragma unroll
                    for (int n = 0; n < 2; ++n) acc[a][b][m][n] = (f32x4){0.f, 0.f, 0.f, 0.f};
        cur = nxt; cA = nA; cB = nB; ++ui;
        if constexpr (ALIGN_EPI) { if (wr == 1) PG8_BAR; }
    }
    PG8_WAIT_V(0);
    if constexpr (!ALIGN_EPI) { if (wr == 0) PG8_BAR; }
    PG8_BAR;
    if constexpr (Epi::AFTER_DRAIN) { E.fused(acc, cur, wr, wc, fr, fq, lds, wid, lane); S.done(cur); }
#undef PG8_SA
#undef PG8_SB
#undef PG8_STAGE
#undef PG8_LDA
#undef PG8_LDB
#undef PG8_MMA
#undef PG8_WAIT_V
#undef PG8_WAIT_L
#undef PG8_BAR
#undef PG8_SCHED
}
}
namespace att {
#define ALAS __attribute__((address_space(3)))
typedef unsigned short bf16_t;
typedef ALAS char* lptr;
typedef ALAS const char* lcptr;
using bf16x8 = __attribute__((ext_vector_type(8))) short;
using s16x4 = __attribute__((ext_vector_type(4))) short;
using f32x16 = __attribute__((ext_vector_type(16))) float;
using f32x4 = __attribute__((ext_vector_type(4))) float;
using u32x4 = __attribute__((ext_vector_type(4))) unsigned;
constexpr int QB = 256, KVB = 64;
constexpr int KSLOT = 12288, VSLOT = 8192;
constexpr int L_K = 0, L_V = 3 * KSLOT, L_WS = L_V + 3 * VSLOT, L_FLAG = L_WS + 2048, L_OST = L_FLAG + 256, L_END = L_OST + 8 * 4096;
#define SBAR() __builtin_amdgcn_sched_barrier(0)
#define WAIT_BAR0() asm volatile("s_waitcnt vmcnt(0) lgkmcnt(0)\n\ts_barrier" ::: "memory")
__device__ __forceinline__ int crow(int r, int hi) { return (r & 3) + 8 * (r >> 2) + 4 * hi; }
__device__ __forceinline__ void glds(const void* g, lptr l) { __builtin_amdgcn_global_load_lds((const unsigned*)g, (ALAS unsigned*)l, 16, 0, 0); }
typedef float f32x2_t __attribute__((ext_vector_type(2))); typedef __bf16 bf16x2_t __attribute__((ext_vector_type(2)));
__device__ __forceinline__ unsigned cvtpk_s(float lo, float hi) { f32x2_t v = {lo, hi}; bf16x2_t b = __builtin_convertvector(v, bf16x2_t); return __builtin_bit_cast(unsigned, b); }
__device__ __forceinline__ float bfu_lo(unsigned w) { return __uint_as_float(w << 16); }
__device__ __forceinline__ float bfu_hi(unsigned w) { return __uint_as_float(w & 0xffff0000u); }

template <int ND> __device__ __forceinline__ void qkt(f32x16& p0, f32x16& p1, lcptr Kslot, const bf16x8* qr, const f32x16& c0, int r32, int hi) {
    lcptr kb = Kslot + hi * 1024 + r32 * 16;
#pragma unroll
    for (int d0 = 0; d0 < ND; ++d0) {
        const bf16x8 b0 = *(const ALAS bf16x8*)(kb + d0 * 2048);
        const bf16x8 b1 = *(const ALAS bf16x8*)(kb + d0 * 2048 + 512);
        if (d0 == 0) { p0 = __builtin_amdgcn_mfma_f32_32x32x16_bf16(b0, qr[0], c0, 0, 0, 0); p1 = __builtin_amdgcn_mfma_f32_32x32x16_bf16(b1, qr[0], c0, 0, 0, 0); }
        else { p0 = __builtin_amdgcn_mfma_f32_32x32x16_bf16(b0, qr[d0], p0, 0, 0, 0); p1 = __builtin_amdgcn_mfma_f32_32x32x16_bf16(b1, qr[d0], p1, 0, 0, 0); }
    }
}
__device__ __forceinline__ void pv(f32x16* o, int vb, bf16x8 pa0, bf16x8 pa1, bf16x8 pa2, bf16x8 pa3) {
#pragma unroll
    for (int d0 = 0; d0 < 2; ++d0) { s16x4 lo[4], hi[4];
#pragma unroll
        for (int ks = 0; ks < 4; ++ks) {
            asm volatile("ds_read_b64_tr_b16 %0,%1 offset:%c2" : "=&v"(lo[ks]) : "v"(vb), "i"(d0 * 4096 + ks * 1024) : "memory");
            asm volatile("ds_read_b64_tr_b16 %0,%1 offset:%c2" : "=&v"(hi[ks]) : "v"(vb), "i"(d0 * 4096 + ks * 1024 + 512) : "memory"); }
        asm volatile("s_waitcnt lgkmcnt(0)" ::: "memory"); SBAR();
#define PK(k) (bf16x8){lo[k][0], lo[k][1], lo[k][2], lo[k][3], hi[k][0], hi[k][1], hi[k][2], hi[k][3]}
        o[d0] = __builtin_amdgcn_mfma_f32_32x32x16_bf16(pa0, PK(0), o[d0], 0, 0, 0);
        o[d0] = __builtin_amdgcn_mfma_f32_32x32x16_bf16(pa1, PK(1), o[d0], 0, 0, 0);
        o[d0] = __builtin_amdgcn_mfma_f32_32x32x16_bf16(pa2, PK(2), o[d0], 0, 0, 0);
        o[d0] = __builtin_amdgcn_mfma_f32_32x32x16_bf16(pa3, PK(3), o[d0], 0, 0, 0);
#undef PK
    }
}
typedef short v4i16_t __attribute__((ext_vector_type(4)));
__device__ __forceinline__ s16x4 vtr(lcptr p) { return __builtin_bit_cast(s16x4, __builtin_amdgcn_ds_read_tr16_b64_v4i16((ALAS v4i16_t*)p)); }
__device__ __forceinline__ void pv2(f32x16* o, lcptr vp, bf16x8 pa0, bf16x8 pa1, bf16x8 pa2, bf16x8 pa3) {
#pragma unroll
    for (int d0 = 0; d0 < 2; ++d0) { bf16x8 vb[4];
#pragma unroll
        for (int ks = 0; ks < 4; ++ks) { const s16x4 lo = vtr(vp + d0 * 4096 + ks * 1024), hi = vtr(vp + d0 * 4096 + ks * 1024 + 512); vb[ks] = __builtin_shufflevector(lo, hi, 0, 1, 2, 3, 4, 5, 6, 7); }
        o[d0] = __builtin_amdgcn_mfma_f32_32x32x16_bf16(pa0, vb[0], o[d0], 0, 0, 0);
        o[d0] = __builtin_amdgcn_mfma_f32_32x32x16_bf16(pa1, vb[1], o[d0], 0, 0, 0);
        o[d0] = __builtin_amdgcn_mfma_f32_32x32x16_bf16(pa2, vb[2], o[d0], 0, 0, 0);
        o[d0] = __builtin_amdgcn_mfma_f32_32x32x16_bf16(pa3, vb[3], o[d0], 0, 0, 0);
    }
}
__device__ __forceinline__ float xhalf_max(float m) { auto rr = __builtin_amdgcn_permlane32_swap(__float_as_uint(m), __float_as_uint(m), false, false); return __builtin_fmaxf(__uint_as_float(rr[0]), __uint_as_float(rr[1])); }
__device__ __forceinline__ float xhalf_sum(float m) { auto rr = __builtin_amdgcn_permlane32_swap(__float_as_uint(m), __float_as_uint(m), false, false); return __uint_as_float(rr[0]) + __uint_as_float(rr[1]); }
#define PKW(P, B) cvtpk_s(P[B], P[B + 1])
__device__ __forceinline__ void store_o(const f32x16* o, const float* rs, lptr shm, int wid, int lane, int r32, int hi, bf16_t* Ow, int opitch) {
    ALAS bf16_t* stg = (ALAS bf16_t*)(shm + L_OST) + wid * 2048;
#pragma unroll
    for (int r = 0; r < 16; ++r) { const int orow = crow(r, hi);
#pragma unroll
        for (int d0 = 0; d0 < 2; ++d0) stg[orow * 64 + d0 * 32 + r32] = (bf16_t)(cvtpk_s(o[d0][r] * rs[r], 0.f) & 0xffffu); }
    asm volatile("s_waitcnt lgkmcnt(0)" ::: "memory");
#pragma unroll
    for (int i = 0; i < 4; ++i) { const int row = i * 8 + (lane >> 3), ch = lane & 7; const u32x4 v = *(const ALAS u32x4*)(stg + row * 64 + ch * 8); *(u32x4*)(Ow + (long)row * opitch + ch * 8) = v; }
}

__device__ __forceinline__ float max3f(float a, float b, float c) { float r; asm("v_max3_f32 %0, %1, %2, %3" : "=v"(r) : "v"(a), "v"(b), "v"(c)); return r; }
template <bool BAND, bool HAS_NEXT>
__device__ __forceinline__ void mla_step(f32x16& pc0, f32x16& pc1, f32x16& pn0, f32x16& pn1, f32x16* o, f32x16& negm, float& mhat, float& l_reg,
                                         lcptr Knext, int vb, const bf16x8* qr, ALAS float* wsf, int jb, int qrel, int r32, int hi) {
    if constexpr (BAND) { const int kb = 64 * jb + 4 * hi;
#pragma unroll
        for (int r = 0; r < 16; ++r) { const int kv = kb + (r & 3) + 8 * (r >> 2); if (kv > qrel) pc0[r] = -INFINITY; if (kv + 32 > qrel) pc1[r] = -INFINITY; } }
    float rm;
    if constexpr (!BAND) {
        float a = max3f(pc0[0], pc0[1], pc1[0]), b2 = max3f(pc0[2], pc0[3], pc1[1]); a = max3f(a, pc1[2], pc1[3]);
#pragma unroll
        for (int r = 4; r < 16; r += 4) { a = max3f(a, pc0[r], pc0[r + 1]); b2 = max3f(b2, pc0[r + 2], pc0[r + 3]); a = max3f(a, pc1[r], pc1[r + 1]); b2 = max3f(b2, pc1[r + 2], pc1[r + 3]); }
        rm = max3f(a, b2, b2);
    } else {
        rm = __builtin_fmaxf(pc0[0], pc1[0]);
#pragma unroll
        for (int r = 1; r < 16; ++r) rm = __builtin_fmaxf(rm, __builtin_fmaxf(pc0[r], pc1[r]));
    }
    rm = xhalf_max(rm);
    if (__builtin_expect(__any(rm > 8.0f), 0)) {
        const float dl = __builtin_fmaxf(rm, 0.f); mhat += dl;
#pragma unroll
        for (int r = 0; r < 16; ++r) { pc0[r] -= dl; pc1[r] -= dl; negm[r] = -mhat; }
        const float f = __builtin_amdgcn_exp2f(-dl); l_reg *= f; if (hi == 0) wsf[r32] = f;
        asm volatile("s_waitcnt lgkmcnt(0)" ::: "memory");
#pragma unroll
        for (int g = 0; g < 4; ++g) { const f32x4 fv = *(const ALAS f32x4*)(wsf + 8 * g + 4 * hi);
#pragma unroll
            for (int i = 0; i < 4; ++i) { o[0][4 * g + i] *= fv[i]; o[1][4 * g + i] *= fv[i]; } }
    }
    if constexpr (HAS_NEXT) qkt<6>(pn0, pn1, Knext, qr, negm, r32, hi);
    float sacc = 0.f;
#pragma unroll
    for (int r = 0; r < 16; ++r) { pc0[r] = __builtin_amdgcn_exp2f(pc0[r]); pc1[r] = __builtin_amdgcn_exp2f(pc1[r]); sacc += pc0[r] + pc1[r]; }
    l_reg += sacc;
    const u32x4 pw0 = (u32x4){PKW(pc0, 0), PKW(pc0, 2), PKW(pc0, 4), PKW(pc0, 6)}, pw1 = (u32x4){PKW(pc0, 8), PKW(pc0, 10), PKW(pc0, 12), PKW(pc0, 14)};
    const u32x4 pw2 = (u32x4){PKW(pc1, 0), PKW(pc1, 2), PKW(pc1, 4), PKW(pc1, 6)}, pw3 = (u32x4){PKW(pc1, 8), PKW(pc1, 10), PKW(pc1, 12), PKW(pc1, 14)};
    if constexpr (HAS_NEXT) {
#pragma unroll
        for (int i = 0; i < 12; ++i) { __builtin_amdgcn_sched_group_barrier(0x008, 1, 0); __builtin_amdgcn_sched_group_barrier(0x002, 8, 0); }
    }
    pv2(o, (lcptr)(uintptr_t)(unsigned)vb, __builtin_bit_cast(bf16x8, pw0), __builtin_bit_cast(bf16x8, pw1), __builtin_bit_cast(bf16x8, pw2), __builtin_bit_cast(bf16x8, pw3));
}
__device__ __forceinline__ void mla_unit(int b, int h, int qb, const bf16_t* Q, const bf16_t* KV, const bf16_t* KPE, const float* COS, const float* SIN, bf16_t* OA, lptr shm) {
    int tid_ = threadIdx.x; asm volatile("" : "+v"(tid_));
    const int tid = tid_, lane = tid & 63, r32 = lane & 31, hi = lane >> 5; const int wid = __builtin_amdgcn_readfirstlane(tid >> 6);
    const long rowbase = (long)b * SEQ; const int q0 = qb * QB;
    const bf16_t* Qw = Q + (rowbase + q0 + wid * 32) * 768 + h * 96;
    const bf16_t* Kh = KV + rowbase * 1024 + h * 128; const bf16_t* Vh = Kh + 64;
    ALAS float* wsf = (ALAS float*)(shm + L_WS) + wid * 64;
    const bf16_t* ksrc = Kh + (long)lane * 1024 + wid * 8;
    const bf16_t* kpsrc = KPE + (rowbase + lane) * 32 + (wid & 3) * 8;
    const bf16_t* vsrc = Vh + (long)(16 * (wid & 3) + (lane >> 2)) * 1024 + (wid >> 2) * 32 + (lane & 3) * 8;
    const int vb0 = (int)(unsigned)(uintptr_t)(shm + L_V) + ((lane >> 4) & 1) * 32 + (lane & 3) * 8 + (4 * hi + ((lane & 15) >> 2)) * 64;
#define MLA_DMA(t, slot) do { glds(ksrc + (long)(t) * KVB * 1024, shm + L_K + (slot) * KSLOT + wid * 1024); \
        if (wid < 4) glds(kpsrc + (long)(t) * KVB * 32, shm + L_K + (slot) * KSLOT + 8192 + wid * 1024); \
        glds(vsrc + (long)(t) * KVB * 1024, shm + L_V + (slot) * VSLOT + wid * 1024); } while (0)
    const int NT = (q0 + QB) / KVB;
    const int Tw = NT - 3 + (wid >> 1);
    MLA_DMA(0, 0); MLA_DMA(1, 1);
    bf16x8 qr[6];
#pragma unroll
    for (int d0 = 0; d0 < 4; ++d0) qr[d0] = *(const bf16x8*)(Qw + (long)r32 * 768 + d0 * 16 + hi * 8);
    {
        const u32x4 x1 = *(const u32x4*)(Qw + (long)r32 * 768 + 64 + hi * 8), x2 = *(const u32x4*)(Qw + (long)r32 * 768 + 80 + hi * 8);
        const float* cp = COS + (rowbase + q0 + wid * 32 + r32) * 16 + hi * 8; const float* sp = SIN + (rowbase + q0 + wid * 32 + r32) * 16 + hi * 8;
        const f32x4 c0 = *(const f32x4*)cp, c1 = *(const f32x4*)(cp + 4), s0 = *(const f32x4*)sp, s1 = *(const f32x4*)(sp + 4);
        const float a[8] = {bfu_lo(x1.x), bfu_hi(x1.x), bfu_lo(x1.y), bfu_hi(x1.y), bfu_lo(x1.z), bfu_hi(x1.z), bfu_lo(x1.w), bfu_hi(x1.w)};
        const float bb[8] = {bfu_lo(x2.x), bfu_hi(x2.x), bfu_lo(x2.y), bfu_hi(x2.y), bfu_lo(x2.z), bfu_hi(x2.z), bfu_lo(x2.w), bfu_hi(x2.w)};
        const float cc[8] = {c0[0], c0[1], c0[2], c0[3], c1[0], c1[1], c1[2], c1[3]}, ss[8] = {s0[0], s0[1], s0[2], s0[3], s1[0], s1[1], s1[2], s1[3]};
        u32x4 o1, o2;
        o1.x = cvtpk_s(a[0] * cc[0] - bb[0] * ss[0], a[1] * cc[1] - bb[1] * ss[1]); o1.y = cvtpk_s(a[2] * cc[2] - bb[2] * ss[2], a[3] * cc[3] - bb[3] * ss[3]);
        o1.z = cvtpk_s(a[4] * cc[4] - bb[4] * ss[4], a[5] * cc[5] - bb[5] * ss[5]); o1.w = cvtpk_s(a[6] * cc[6] - bb[6] * ss[6], a[7] * cc[7] - bb[7] * ss[7]);
        o2.x = cvtpk_s(a[0] * ss[0] + bb[0] * cc[0], a[1] * ss[1] + bb[1] * cc[1]); o2.y = cvtpk_s(a[2] * ss[2] + bb[2] * cc[2], a[3] * ss[3] + bb[3] * cc[3]);
        o2.z = cvtpk_s(a[4] * ss[4] + bb[4] * cc[4], a[5] * ss[5] + bb[5] * cc[5]); o2.w = cvtpk_s(a[6] * ss[6] + bb[6] * cc[6], a[7] * ss[7] + bb[7] * cc[7]);
        qr[4] = __builtin_bit_cast(bf16x8, o1); qr[5] = __builtin_bit_cast(bf16x8, o2);
    }
    float mhat = 0.f, l_reg = 0.f; f32x16 o[2]; o[0] = f32x16{}; o[1] = f32x16{}; f32x16 negm = f32x16{};
    const int qrel = wid * 32 + r32;
    f32x16 pA0, pA1, pB0, pB1;
    WAIT_BAR0();
    MLA_DMA(2, 2);
    qkt<6>(pA0, pA1, (lcptr)(shm + L_K), qr, negm, r32, hi);
    if (NT == 4) { const int kb = 4 * hi;
#pragma unroll
        for (int r = 0; r < 16; ++r) { const int kv = kb + (r & 3) + 8 * (r >> 2); if (kv > qrel) pA0[r] = -INFINITY; if (kv + 32 > qrel) pA1[r] = -INFINITY; } }
    { float rm = __builtin_fmaxf(pA0[0], pA1[0]);
#pragma unroll
      for (int r = 1; r < 16; ++r) rm = __builtin_fmaxf(rm, __builtin_fmaxf(pA0[r], pA1[r]));
      rm = xhalf_max(rm); mhat = rm;
#pragma unroll
      for (int r = 0; r < 16; ++r) { pA0[r] -= rm; pA1[r] -= rm; negm[r] = -mhat; } }
    int s_cur = 0, s_nxt = 1, s_fre = 2;
#define MLA_SEAM(t_) do { if ((t_) > 0) { WAIT_BAR0(); if ((t_) + 2 < NT) MLA_DMA((t_) + 2, s_fre); } } while (0)
#define MLA_ROT() do { const int x_ = s_cur; s_cur = s_nxt; s_nxt = s_fre; s_fre = x_; } while (0)
    for (int t = 0; t < NT - 4; t += 2) {
        MLA_SEAM(t);
        mla_step<false, true>(pA0, pA1, pB0, pB1, o, negm, mhat, l_reg, (lcptr)(shm + L_K + s_nxt * KSLOT), vb0 + s_cur * VSLOT, qr, wsf, 0, qrel, r32, hi);
        MLA_ROT();
        MLA_SEAM(t + 1);
        mla_step<false, true>(pB0, pB1, pA0, pA1, o, negm, mhat, l_reg, (lcptr)(shm + L_K + s_nxt * KSLOT), vb0 + s_cur * VSLOT, qr, wsf, 0, qrel, r32, hi);
        MLA_ROT();
    }
    for (int t = NT - 4; t < NT; ++t) {
        MLA_SEAM(t);
        if (t < Tw) {
            if (t > NT - 4) qkt<6>(pA0, pA1, (lcptr)(shm + L_K + s_cur * KSLOT), qr, negm, r32, hi);
            mla_step<true, false>(pA0, pA1, pB0, pB1, o, negm, mhat, l_reg, (lcptr)(shm + L_K), vb0 + s_cur * VSLOT, qr, wsf, t - (NT - 4), qrel, r32, hi);
        }
        MLA_ROT();
    }
#undef MLA_SEAM
#undef MLA_ROT
#undef MLA_DMA
    l_reg = xhalf_sum(l_reg);
    if (hi == 0) wsf[32 + r32] = l_reg; asm volatile("s_waitcnt lgkmcnt(0)" ::: "memory");
    float rli[16];
#pragma unroll
    for (int r = 0; r < 16; ++r) rli[r] = __builtin_amdgcn_rcpf(wsf[32 + crow(r, hi)]);
    store_o(o, rli, shm, wid, lane, r32, hi, OA + (rowbase + q0 + wid * 32) * 1024 + h * 64, 1024);
    asm volatile("s_waitcnt lgkmcnt(0)\n\ts_barrier" ::: "memory");
}

__device__ __forceinline__ void sb_unit(int b, int h, int qb, const bf16_t* PROJ, bf16_t* OB, lptr shm) {
    int tid_ = threadIdx.x; asm volatile("" : "+v"(tid_));
    const int tid = tid_, lane = tid & 63, r32 = lane & 31, hi = lane >> 5; const int wid = __builtin_amdgcn_readfirstlane(tid >> 6);
    const long rowbase = (long)b * SEQ; const int q0 = qb * QB;
    const bf16_t* Qw = PROJ + (rowbase + q0 + wid * 32) * DINP + C_QSB + h * 64;
    const bf16_t* Kh = PROJ + rowbase * DINP + C_KSB + h * 64; const bf16_t* Vh = PROJ + rowbase * DINP + C_VSB + h * 64;
    const bf16_t* ksrc = Kh + (long)lane * DINP + wid * 8;
    const bf16_t* vsrc = Vh + (long)(16 * (wid & 3) + (lane >> 2)) * DINP + (wid >> 2) * 32 + (lane & 3) * 8;
    const int vb0 = (int)(unsigned)(uintptr_t)(shm + L_V) + ((lane >> 4) & 1) * 32 + (lane & 3) * 8 + (4 * hi + ((lane & 15) >> 2)) * 64;
    ALAS unsigned* flags = (ALAS unsigned*)(shm + L_FLAG);
#define SB_DMA(t, slot) do { glds(ksrc + (long)(t) * KVB * DINP, shm + L_K + (slot) * KSLOT + wid * 1024); \
        glds(vsrc + (long)(t) * KVB * DINP, shm + L_V + (slot) * VSLOT + wid * 1024); } while (0)
    const int NT = (q0 + QB) / KVB;
    int t = NT - 1;
    SB_DMA(t, 0);
    bf16x8 qr[4];
#pragma unroll
    for (int d0 = 0; d0 < 4; ++d0) qr[d0] = *(const bf16x8*)(Qw + (long)r32 * DINP + d0 * 16 + hi * 8);
    f32x16 o[2]; o[0] = f32x16{}; o[1] = f32x16{}; const f32x16 zero16 = f32x16{};
    float R = 1.0f;
    const int qrel = wid * 32 + r32;
    for (int i = 0;; ++i) {
        WAIT_BAR0();
        if (i > 0) { unsigned all = 1u;
#pragma unroll
            for (int w = 0; w < 8; ++w) all &= flags[((i - 1) & 1) * 8 + w];
            if (all) break; }
        if (t > 0) SB_DMA(t - 1, (i + 1) & 1);
        const int jb = t - (NT - 4);
        const bool skip = (jb >= 0 && 64 * jb >= 32 * wid + 31) || __all(R == 0.0f);
        if (!skip) {
            f32x16 z0, z1;
            qkt<4>(z0, z1, (lcptr)(shm + L_K + (i & 1) * KSLOT), qr, zero16, r32, hi);
            float M0[16], M1[16];
            if (jb >= 0) {
#pragma unroll
                for (int r = 0; r < 16; ++r) { const int kv = 64 * jb + crow(r, hi);
                    { const float om = __builtin_amdgcn_rcpf(1.0f + __builtin_amdgcn_exp2f(z0[r])); M0[r] = (kv >= qrel) ? 1.0f : om; }
                    { const float om = __builtin_amdgcn_rcpf(1.0f + __builtin_amdgcn_exp2f(z1[r])); M1[r] = (kv + 32 >= qrel) ? 1.0f : om; } }
            } else {
#pragma unroll
                for (int r = 0; r < 16; ++r) { M0[r] = __builtin_amdgcn_rcpf(1.0f + __builtin_amdgcn_exp2f(z0[r])); M1[r] = __builtin_amdgcn_rcpf(1.0f + __builtin_amdgcn_exp2f(z1[r])); }
            }
            float G[8], PG[8], ST[8], W0[16], W1[16];
            { float link = 0.f;
#pragma unroll
              for (int g = 0; g < 4; ++g) { float p = M0[4 * g]; asm volatile("" : "+v"(p) : "v"(link)); p *= M0[4 * g + 1]; p *= M0[4 * g + 2]; p *= M0[4 * g + 3]; G[g] = p; link = p;
                                            float q = M1[4 * g]; asm volatile("" : "+v"(q) : "v"(link)); q *= M1[4 * g + 1]; q *= M1[4 * g + 2]; q *= M1[4 * g + 3]; G[4 + g] = q; link = q; } }
#pragma unroll
            for (int j = 0; j < 8; ++j) PG[j] = __shfl_xor(G[j], 32);
            ST[7] = 1.0f;
#pragma unroll
            for (int j = 6; j >= 0; --j) ST[j] = ST[j + 1] * (G[j + 1] * PG[j + 1]);
            const float total = ST[0] * (G[0] * PG[0]);
            { float link = 0.f;
#pragma unroll
              for (int g = 0; g < 4; ++g) {
                { float after = R * ST[g] * (hi == 0 ? PG[g] : 1.0f); asm volatile("" : "+v"(after) : "v"(link));
#pragma unroll
                  for (int ii = 3; ii >= 0; --ii) { const float om = M0[4 * g + ii]; W0[4 * g + ii] = __builtin_fmaf(-after, om, after); after *= om; }
                  link = after; }
                { float after = R * ST[4 + g] * (hi == 0 ? PG[4 + g] : 1.0f); asm volatile("" : "+v"(after) : "v"(link));
#pragma unroll
                  for (int ii = 3; ii >= 0; --ii) { const float om = M1[4 * g + ii]; W1[4 * g + ii] = __builtin_fmaf(-after, om, after); after *= om; }
                  link = after; }
              } }
            R *= total;
            const u32x4 pw0 = (u32x4){PKW(W0, 0), PKW(W0, 2), PKW(W0, 4), PKW(W0, 6)}, pw1 = (u32x4){PKW(W0, 8), PKW(W0, 10), PKW(W0, 12), PKW(W0, 14)};
            const u32x4 pw2 = (u32x4){PKW(W1, 0), PKW(W1, 2), PKW(W1, 4), PKW(W1, 6)}, pw3 = (u32x4){PKW(W1, 8), PKW(W1, 10), PKW(W1, 12), PKW(W1, 14)};
            SBAR();
            pv2(o, (lcptr)(uintptr_t)(unsigned)(vb0 + (i & 1) * VSLOT), __builtin_bit_cast(bf16x8, pw0), __builtin_bit_cast(bf16x8, pw1), __builtin_bit_cast(bf16x8, pw2), __builtin_bit_cast(bf16x8, pw3));
        }
        const unsigned done_w = __all(R == 0.0f) ? 1u : 0u;
        if (lane == 0) flags[(i & 1) * 8 + wid] = done_w;
        if (t == 0) break;
        --t;
    }
#undef SB_DMA
    float one[16];
#pragma unroll
    for (int r = 0; r < 16; ++r) one[r] = 1.0f;
    store_o(o, one, shm, wid, lane, r32, hi, OB + (rowbase + q0 + wid * 32) * 1024 + 512 + h * 64, 1024);
    asm volatile("s_waitcnt lgkmcnt(0)\n\ts_barrier" ::: "memory");
}
#undef PKW
#undef SBAR
#undef WAIT_BAR0
}

#define GAS __attribute__((address_space(1)))
#define LAS __attribute__((address_space(3)))
typedef unsigned short bf16;
typedef unsigned v4u __attribute__((ext_vector_type(4)));
typedef unsigned v2u __attribute__((ext_vector_type(2)));
typedef float f32x4 __attribute__((ext_vector_type(4)));
constexpr int NWAVES = 8;
constexpr size_t MiB = 1u << 20;
constexpr size_t WS_WIN = 2 * MiB, WS_WQB = 11 * MiB, WS_WKVB = 12 * MiB, WS_WBRA = 13 * MiB, WS_WBRB = 14 * MiB, WS_WOUT = 15 * MiB, WS_WGU = 17 * MiB, WS_WDN = 28 * MiB, WS_WPG = 34 * MiB, WS_WPP = 36 * MiB;
constexpr size_t WS_COS = 40 * MiB, WS_SIN = 42 * MiB, WS_KPE = 44 * MiB, WS_PB = 48 * MiB;
constexpr size_t WS_XN = 64 * MiB;
constexpr size_t WS_CQN = 64 * MiB, WS_CKVN = 88 * MiB, WS_OA = 64 * MiB, WS_OB = 96 * MiB;
constexpr size_t WS_PROJ = 128 * MiB;
constexpr size_t WS_ACT = 128 * MiB, WS_EP = 304 * MiB, WS_GS = 368 * MiB;
constexpr size_t WS_Q = 400 * MiB, WS_KV = 448 * MiB;
constexpr size_t WS_MERGED = 448 * MiB, WS_H2B = 448 * MiB, WS_END = 512 * MiB;
static_assert(WS_PROJ + (size_t)NTOK * DINP * 2 <= WS_Q && WS_ACT + (size_t)NTOK * DFF * 2 <= WS_EP && WS_GS + (size_t)NTOK * DM * 2 <= WS_KV && WS_Q + (size_t)NTOK * 768 * 2 <= WS_KV, "ws map");
static_assert(WS_WIN + (size_t)DINP * DM * 2 <= WS_WQB && WS_WGU + (size_t)2 * DFF * DM * 2 <= WS_WDN && WS_WDN + (size_t)DFF * DM * 2 <= WS_WPG, "ws weights");
constexpr int LDS_BYTES = 131072 + 1024;
static_assert(att::L_END <= 131072, "attention LDS");

__device__ __forceinline__ unsigned f2bf(float f) { unsigned u = __builtin_bit_cast(unsigned, f); return (u + 0x7fffu + ((u >> 16) & 1u)) >> 16; }
__device__ __forceinline__ unsigned pk2(float lo, float hi) { return f2bf(lo) | (f2bf(hi) << 16); }
__device__ __forceinline__ float wave_sum(float v) {
#pragma unroll
    for (int o = 1; o < 64; o <<= 1) v += __shfl_xor(v, o);
    return v;
}
__device__ __forceinline__ int dest_row(int mode, int n0) {
    if (mode == 1) {
        if (n0 < 672) return n0;
        if (n0 < 2208) return n0 + 96;
        if (n0 < 3232) { const int j = n0 - 2208; return 2304 + 256 * (j >> 7) + (j & 127); }
        const int j = n0 - 3232; return 2304 + 256 * (j >> 7) + 128 + (j & 127);
    }
    if (mode == 2) return 256 * (n0 >> 7) + (n0 & 127);
    if (mode == 3) return 256 * (n0 >> 7) + 128 + (n0 & 127);
    return n0;
}
__device__ __forceinline__ void transpose_item(const float* W, int K, int N, bf16* WT, int mode, LAS float* scr, int item, int lane, const float* gk = nullptr, int ldk = 0, int koff = 0) {
    const int nblk = N / 32, kb = item / nblk, nb = item % nblk, k0 = 64 * kb, n0 = 32 * nb;
    const int dr = dest_row(mode, n0);
#pragma unroll 8
    for (int i = 0; i < 32; ++i) { const int kk = 2 * i + (lane >> 5); float w = __builtin_nontemporal_load(W + (size_t)(k0 + kk) * N + n0 + (lane & 31)); if (gk) w *= gk[k0 + kk]; scr[kk * 33 + (lane & 31)] = w; }
    asm volatile("s_waitcnt lgkmcnt(0)" ::: "memory");
    const int c = lane & 7;
#pragma unroll
    for (int j = 0; j < 4; ++j) { const int n = (lane >> 3) + 8 * j; const LAS float* s = scr + (8 * c) * 33 + n;
        v4u o; o.x = pk2(s[0 * 33], s[1 * 33]); o.y = pk2(s[2 * 33], s[3 * 33]); o.z = pk2(s[4 * 33], s[5 * 33]); o.w = pk2(s[6 * 33], s[7 * 33]);
        *(v4u*)(WT + (size_t)(dr + n) * (ldk ? ldk : K) + koff + k0 + 8 * c) = o; }
    asm volatile("s_waitcnt lgkmcnt(0)" ::: "memory");
}
template <int R> __device__ __forceinline__ void rms_rows_to_bf16(const float* src, const float* g, bf16* dst, int m0, int mstride, int lane) {
    f32x4 v[R][4]; float s[R];
#pragma unroll
    for (int r = 0; r < R; ++r) { const f32x4* xr = (const f32x4*)(src + (size_t)(m0 + r * mstride) * DM) + lane;
#pragma unroll
        for (int j = 0; j < 4; ++j) v[r][j] = xr[64 * j]; }
    f32x4 gg[4];
#pragma unroll
    for (int j = 0; j < 4; ++j) gg[j] = ((const f32x4*)g + lane)[64 * j];
#pragma unroll
    for (int r = 0; r < R; ++r) { s[r] = 0.f;
#pragma unroll
        for (int j = 0; j < 4; ++j) s[r] += (v[r][j].x * v[r][j].x + v[r][j].y * v[r][j].y) + (v[r][j].z * v[r][j].z + v[r][j].w * v[r][j].w); }
#pragma unroll
    for (int o = 1; o < 64; o <<= 1) {
#pragma unroll
        for (int r = 0; r < R; ++r) s[r] += __shfl_xor(s[r], o); }
#pragma unroll
    for (int r = 0; r < R; ++r) { const float rstd = 1.0f / sqrtf(s[r] * (1.f / DM) + EPS); v2u* o8 = (v2u*)(dst + (size_t)(m0 + r * mstride) * DM) + lane;
#pragma unroll
        for (int j = 0; j < 4; ++j) { v2u w; w.x = pk2(v[r][j].x * rstd * gg[j].x, v[r][j].y * rstd * gg[j].y); w.y = pk2(v[r][j].z * rstd * gg[j].z, v[r][j].w * rstd * gg[j].w); o8[64 * j] = w; } }
}
template <int R> __device__ __forceinline__ void rms_rows_bf16_to_bf16(const bf16* src, const float* g, bf16* dst, int m0, int mstride, int lane) {
    f32x4 v[R][4]; float s[R];
#pragma unroll
    for (int r = 0; r < R; ++r) { const v2u* xr = (const v2u*)(src + (size_t)(m0 + r * mstride) * DM) + lane;
#pragma unroll
        for (int j = 0; j < 4; ++j) { const v2u w = xr[64 * j]; v[r][j] = (f32x4){pg8::bf_lo(w.x), pg8::bf_hi(w.x), pg8::bf_lo(w.y), pg8::bf_hi(w.y)}; } }
    f32x4 gg[4];
#pragma unroll
    for (int j = 0; j < 4; ++j) gg[j] = ((const f32x4*)g + lane)[64 * j];
#pragma unroll
    for (int r = 0; r < R; ++r) { s[r] = 0.f;
#pragma unroll
        for (int j = 0; j < 4; ++j) s[r] += (v[r][j].x * v[r][j].x + v[r][j].y * v[r][j].y) + (v[r][j].z * v[r][j].z + v[r][j].w * v[r][j].w); }
#pragma unroll
    for (int o = 1; o < 64; o <<= 1) {
#pragma unroll
        for (int r = 0; r < R; ++r) s[r] += __shfl_xor(s[r], o); }
#pragma unroll
    for (int r = 0; r < R; ++r) { const float rstd = 1.0f / sqrtf(s[r] * (1.f / DM) + EPS); v2u* o8 = (v2u*)(dst + (size_t)(m0 + r * mstride) * DM) + lane;
#pragma unroll
        for (int j = 0; j < 4; ++j) { v2u w; w.x = pk2(v[r][j].x * rstd * gg[j].x, v[r][j].y * rstd * gg[j].y); w.y = pk2(v[r][j].z * rstd * gg[j].z, v[r][j].w * rstd * gg[j].w); o8[64 * j] = w; } }
}
__device__ __forceinline__ float inv_freq(int j) {
    const float b = (j & 2) ? ((j & 1) ? 0.17782794100389228f : 0.31622776601683794f) : ((j & 1) ? 0.5623413251903491f : 1.0f);
    const float s = (j & 8) ? ((j & 4) ? 0.001f : 0.01f) : ((j & 4) ? 0.1f : 1.0f);
    return b * s;
}


typedef unsigned gu32_t;
#define XB_TMO      128
#define XB_XCNT(j)  (256  + 64 * (j))
#define XB_XSUB(j)  (1280 + 64 * (j))
#define XB_XGEN(j)  (2304 + 64 * (j))
#define XB_TOP      3328
#define XB_TOPGEN   3392
#define XCD_BAR_WORDS 3456
#define XB_SPIN_CAP (1u << 18)

__device__ __forceinline__ unsigned xb_ld(unsigned* p)              { return __hip_atomic_load(p, __ATOMIC_RELAXED, __HIP_MEMORY_SCOPE_AGENT); }
__device__ __forceinline__ unsigned xb_add(unsigned* p, unsigned v) { return __hip_atomic_fetch_add(p, v, __ATOMIC_RELAXED, __HIP_MEMORY_SCOPE_AGENT); }
__device__ __forceinline__ unsigned xb_xcc_id() { return (unsigned)__builtin_amdgcn_s_getreg((3 << 11) | 20) & 0xFu; }
#define XB_SPIN(cond, bar) do { unsigned _sp = 0; while (cond) { __builtin_amdgcn_s_sleep(1); \
    if ((++_sp & 255u) == 0u) { if (xb_ld(&(bar)[XB_TMO])) break; if (_sp > XB_SPIN_CAP) { atomicAdd(&(bar)[XB_TMO], 1u); break; } } } } while (0)

struct XcdBarrier {
    unsigned* bar; unsigned x;
    volatile LAS unsigned* st;
};

__device__ __forceinline__ XcdBarrier xcd_barrier_post(unsigned* bar, volatile LAS unsigned* st) {
    XcdBarrier b; b.bar = bar; b.x = xb_xcc_id(); b.st = st;
    if (threadIdx.x == 0) (void)xb_add(&bar[XB_XCNT(b.x)], 1u);
    return b;
}
__device__ __forceinline__ void xcd_barrier_complete(unsigned* bar, unsigned x, unsigned& nloc, unsigned& nx) {
    const unsigned G = gridDim.x * gridDim.y * gridDim.z;
    unsigned sum, cnt, mine, sp = 0u;
    for (;;) {
        sum = 0u; cnt = 0u; mine = 0u;
#pragma unroll
        for (unsigned j = 0; j < 16; ++j) { const unsigned c = xb_ld(&bar[XB_XCNT(j)]); sum += c; cnt += (c > 0u) ? 1u : 0u; mine = (j == x) ? c : mine; }
        if (sum == G) break;
        __builtin_amdgcn_s_sleep(1);
        if ((++sp & 255u) == 0u) { if (xb_ld(&bar[XB_TMO])) break; if (sp > XB_SPIN_CAP) { atomicAdd(&bar[XB_TMO], 1u); break; } }
    }
    nloc = mine > 0u ? mine : 1u; nx = cnt > 0u ? cnt : 1u;
}

__device__ __forceinline__ void xcd_barrier(const XcdBarrier& b) {
    asm volatile("s_waitcnt vmcnt(0)" ::: "memory");
    __syncthreads();
    if (threadIdx.x == 0) {
        unsigned* bar = b.bar;
        __builtin_amdgcn_s_waitcnt(0);
        unsigned nloc = b.st[0], nx = b.st[1];
        if (nloc == 0u) { xcd_barrier_complete(bar, b.x, nloc, nx); b.st[0] = nloc; b.st[1] = nx; }
        const unsigned old = xb_add(&bar[XB_XSUB(b.x)], 1u);
        const unsigned gen = old / nloc;
        if (old + 1u == (gen + 1u) * nloc) {
            __builtin_amdgcn_fence(__ATOMIC_RELEASE, "agent");
            asm volatile("s_waitcnt vmcnt(0)" ::: "memory");
            const unsigned og = xb_add(&bar[XB_TOP], 1u);
            const unsigned tg = og / nx;
            if (og + 1u == (tg + 1u) * nx) xb_add(&bar[XB_TOPGEN], 1u);
            else XB_SPIN(xb_ld(&bar[XB_TOPGEN]) == tg, bar);
            __builtin_amdgcn_fence(__ATOMIC_ACQUIRE, "agent");
            xb_add(&bar[XB_XGEN(b.x)], 1u);
            asm volatile("s_waitcnt vmcnt(0)" ::: "memory");
        } else {
            XB_SPIN(xb_ld(&bar[XB_XGEN(b.x)]) == gen, bar);
            __builtin_amdgcn_fence(__ATOMIC_ACQUIRE, "agent");
            asm volatile("s_waitcnt vmcnt(0)" ::: "memory");
        }
    }
    __syncthreads();
}

struct Args { const void* in[20]; float* out; unsigned char* ws; };
#define CG_SYNC() do { asm volatile("s_waitcnt vmcnt(0) lgkmcnt(0)" ::: "memory"); __syncthreads(); grid.sync(); \
    if (threadIdx.x < 64) { __builtin_amdgcn_fence(__ATOMIC_ACQUIRE, "agent"); asm volatile("s_waitcnt vmcnt(0)" ::: "memory"); }     \
    __syncthreads(); } while (0)
#define GRID_SYNC() xcd_barrier(xbar)

__global__ void __launch_bounds__(NWAVES * 64, 2) fwd_megakernel(Args args) {
    extern __shared__ __attribute__((aligned(16))) unsigned char lds_raw[];
    cg::grid_group grid = cg::this_grid();
    LAS unsigned char* lds = (LAS unsigned char*)lds_raw;
    int tid = threadIdx.x, lane = tid & 63; const int wave = __builtin_amdgcn_readfirstlane(tid >> 6);
    const int G = gridDim.x, bx = blockIdx.x;
    const int vcu = (G % 8 == 0) ? (bx % 8) * (G / 8) + bx / 8 : bx;
    const int gw = vcu * NWAVES + wave, NGW = G * NWAVES;
    int gt = bx * (NWAVES * 64) + tid; const int NGT = G * NWAVES * 64;
    unsigned char* ws = args.ws;
    volatile LAS unsigned* MISC = (volatile LAS unsigned*)(lds + 131072);
    if (tid < 64) MISC[tid] = 0u;
    __syncthreads();
    XcdBarrier xbar = xcd_barrier_post((unsigned*)ws + 1024, MISC + 8);
    const float* x = (const float*)args.in[0]; const float* pin = (const float*)args.in[1]; const int* positions = (const int*)args.in[2];
    const float* g_mix = (const float*)args.in[3]; const float* w_in = (const float*)args.in[4]; const float* g_q_a = (const float*)args.in[5]; const float* w_q_b = (const float*)args.in[6];
    const float* g_kv_a = (const float*)args.in[7]; const float* w_kv_b = (const float*)args.in[8]; const float* w_br_mla = (const float*)args.in[9]; const float* w_br_sb = (const float*)args.in[10];
    const float* w_out = (const float*)args.in[11]; const float* g_ffn = (const float*)args.in[12]; const float* w_ffn_gate = (const float*)args.in[13]; const float* w_ffn_up = (const float*)args.in[14];
    const float* w_ffn_down = (const float*)args.in[15]; const float* w_ple_gate = (const float*)args.in[16]; const float* w_ple_proj = (const float*)args.in[17]; const float* g_ple = (const float*)args.in[18];
    const float* g_final = (const float*)args.in[19];
    float* H = args.out;
    unsigned char* wsq = ws;
#define NEWPHASE() do { wsq = ws; asm volatile("" : "+s"(wsq)); tid = threadIdx.x; asm volatile("" : "+v"(tid)); lane = tid & 63; gt = bx * (NWAVES * 64) + tid; } while (0)
#define WIN ((bf16*)(wsq + (WS_WIN)))
#define WQB ((bf16*)(wsq + (WS_WQB)))
#define WKVB ((bf16*)(wsq + (WS_WKVB)))
#define WBRA ((bf16*)(wsq + (WS_WBRA)))
#define WBRB ((bf16*)(wsq + (WS_WBRB)))
#define WOUT ((bf16*)(wsq + (WS_WOUT)))
#define WGU ((bf16*)(wsq + (WS_WGU)))
#define WDN ((bf16*)(wsq + (WS_WDN)))
#define WPG ((bf16*)(wsq + (WS_WPG)))
#define WPP ((bf16*)(wsq + (WS_WPP)))
#define SSQ ((float*)(wsq + (37 * MiB)))
#define SSKV ((float*)(wsq + (46 * MiB)))
#define COS ((float*)(wsq + (WS_COS)))
#define SIN ((float*)(wsq + (WS_SIN)))
#define KPE ((bf16*)(wsq + (WS_KPE)))
#define PB ((bf16*)(wsq + (WS_PB)))
#define XN ((bf16*)(wsq + (WS_XN)))
#define CQN ((bf16*)(wsq + (WS_CQN)))
#define CKVN ((bf16*)(wsq + (WS_CKVN)))
#define OA ((bf16*)(wsq + (WS_OA)))
#define OB ((bf16*)(wsq + (WS_OB)))
#define PROJ ((bf16*)(wsq + (WS_PROJ)))
#define ACT ((bf16*)(wsq + (WS_ACT)))
#define EP ((bf16*)(wsq + (WS_EP)))
#define GS ((bf16*)(wsq + (WS_GS)))
#define H1B ((bf16*)(wsq + (WS_EP)))
#define Qb ((bf16*)(wsq + (WS_Q)))
#define KVb ((bf16*)(wsq + (WS_KV)))
#define MERGED ((bf16*)(wsq + (WS_MERGED)))
#define H2B ((bf16*)(wsq + (WS_H2B)))

    NEWPHASE();
    {
        LAS float* scr = (LAS float*)(lds + wave * 16384);
        constexpr int I_IN = 16 * 133, I_QB = 6 * 24, I_KVB = 4 * 32, I_BR = 8 * 32, I_OUT = 16 * 32, I_G = 16 * 88, I_DN = 44 * 32, I_PG = 16 * 32, I_PP = 4 * 32;
        constexpr int NITEMS = I_IN + I_QB + I_KVB + 2 * I_BR + I_OUT + 2 * I_G + I_DN + I_PG + I_PP;
        for (int it = gw; it < NITEMS; it += NGW) {
            int r = it;
            if (r < I_IN) { transpose_item(w_in, 1024, 4256, WIN, 1, scr, r, lane); continue; } r -= I_IN;
            if (r < I_QB) { transpose_item(w_q_b, 384, 768, WQB, 0, scr, r, lane, g_q_a); continue; } r -= I_QB;
            if (r < I_KVB) { transpose_item(w_kv_b, 256, 1024, WKVB, 0, scr, r, lane, g_kv_a); continue; } r -= I_KVB;
            if (r < I_BR) { transpose_item(w_br_mla, 512, 1024, WBRA, 0, scr, r, lane, nullptr, 1024, 0); continue; } r -= I_BR;
            if (r < I_BR) { transpose_item(w_br_sb, 512, 1024, WBRA, 0, scr, r, lane, nullptr, 1024, 512); continue; } r -= I_BR;
            if (r < I_OUT) { transpose_item(w_out, 1024, 1024, WOUT, 0, scr, r, lane); continue; } r -= I_OUT;
            if (r < I_G) { transpose_item(w_ffn_gate, 1024, 2816, WGU, 2, scr, r, lane); continue; } r -= I_G;
            if (r < I_G) { transpose_item(w_ffn_up, 1024, 2816, WGU, 3, scr, r, lane); continue; } r -= I_G;
            if (r < I_DN) { transpose_item(w_ffn_down, 2816, 1024, WDN, 0, scr, r, lane); continue; } r -= I_DN;
            if (r < I_PG) { transpose_item(w_ple_gate, 1024, 1024, WPG, 0, scr, r, lane); continue; } r -= I_PG;
            transpose_item(w_ple_proj, 256, 1024, WPP, 0, scr, r, lane);
        }
        for (int i = gt; i < 96 * 1024 / 8; i += NGT) *(v4u*)(WIN + (size_t)672 * 1024 + (size_t)i * 8) = (v4u){0u, 0u, 0u, 0u};
        for (int m = gw; m < NTOK; m += 4 * NGW) rms_rows_to_bf16<4>(x, g_mix, XN, m, NGW, lane);
        for (int i = gt; i < NTOK * PLE / 8; i += NGT) { const f32x4 a = __builtin_nontemporal_load((const f32x4*)(pin + (size_t)i * 8)), b = __builtin_nontemporal_load((const f32x4*)(pin + (size_t)i * 8 + 4));
            v4u o; o.x = pk2(a.x, a.y); o.y = pk2(a.z, a.w); o.z = pk2(b.x, b.y); o.w = pk2(b.z, b.w); *(v4u*)(PB + (size_t)i * 8) = o; }
        for (int i = gt; i < NTOK * 16; i += NGT) { const int m = i >> 4, j = i & 15; const float ang = (float)positions[m] * inv_freq(j);
            const double rev = (double)ang * 0.15915494309189535; const float fr = (float)(rev - __builtin_floor(rev));
            COS[i] = __builtin_amdgcn_cosf(fr); SIN[i] = __builtin_amdgcn_sinf(fr); }
    }
    if (__builtin_expect(args.ws == nullptr, 0)) CG_SYNC();
    GRID_SYNC();

    NEWPHASE();
    { pg8::Gemm g{XN, WIN, NTOK, DINP, DM}; pg8::StaticOrder S; S.init(NTOK, DINP, G, bx);
      pg8::Epi<pg8::M_PROJ> E{PROJ, DINP, nullptr, 0, nullptr, nullptr, 1.f, (float*)ws, 0, 0.f};
      pg8::gemm_phase<pg8::Epi<pg8::M_PROJ>, pg8::StaticOrder, true, true>(lds, g, S, E); }
    GRID_SYNC();


    NEWPHASE();
    { pg8::Gemm g{PROJ + C_CQ, WQB, NTOK, 768, QRANK, DINP}; pg8::StaticOrder S; S.init(NTOK, 768, G, bx);
      pg8::Epi<pg8::M_SCALER> E{Qb, 768, nullptr, 0, nullptr, nullptr, MLA_C2, SSQ, 12, 1.f / QRANK};
      pg8::gemm_phase<pg8::Epi<pg8::M_SCALER>, pg8::StaticOrder, true, true>(lds, g, S, E); }
    { pg8::Gemm g{PROJ + C_CKV, WKVB, NTOK, 1024, KVRANK, DINP}; pg8::StaticOrder S; S.init(NTOK, 1024, G, bx);
      pg8::Epi<pg8::M_SCALER> E{KVb, 1024, nullptr, 0, nullptr, nullptr, 1.f, SSKV, 8, 1.f / KVRANK};
      pg8::gemm_phase<pg8::Epi<pg8::M_SCALER>, pg8::StaticOrder, true, true>(lds, g, S, E); }
    GRID_SYNC();

    NEWPHASE();
    for (int i = 0;; ++i) { const int idx = i * G + vcu; if (idx >= 1024) break;
        const int rnd = idx >> 8, v = idx & 255, bh = v >> 2, s = v & 3; const int qb = (rnd == 0) ? 15 - s : (rnd == 1) ? 8 + s : (rnd == 2) ? 7 - s : s;
        att::mla_unit(bh >> 3, bh & 7, qb, Qb, KVb, KPE, COS, SIN, OA, (att::lptr)lds); }
    for (int i = 0;; ++i) { const int idx = i * G + vcu; if (idx >= 1024) break;
        const int rnd = idx >> 8, v = idx & 255, bh = v >> 2, s = v & 3; const int qb = (rnd == 0) ? 15 - s : (rnd == 1) ? 8 + s : (rnd == 2) ? 7 - s : s;
        att::sb_unit(bh >> 3, bh & 7, qb, PROJ, OA, (att::lptr)lds); }
    GRID_SYNC();

    NEWPHASE();
    { pg8::Gemm g{OA, WBRA, NTOK, 1024, 512, 1024, 1024}; pg8::SplitOrder S; S.base.init(NTOK, 1024, G, bx);
      pg8::Epi<pg8::M_GATEF> E{MERGED, 1024, PROJ + C_GA, DINP, nullptr, nullptr, 1.f, nullptr, 0, 0.f};
      pg8::gemm_phase<pg8::Epi<pg8::M_GATEF>, pg8::SplitOrder, true, true>(lds, g, S, E); }
    GRID_SYNC();

    NEWPHASE();
    { pg8::Gemm g{MERGED, WOUT, NTOK, 1024, 1024}; pg8::StaticOrder S; S.init(NTOK, 1024, G, bx);
      pg8::Epi<pg8::M_RES> E{H1B, 1024, nullptr, 0, x, nullptr, 1.f, nullptr, 0, 0.f};
      pg8::gemm_phase<pg8::Epi<pg8::M_RES>, pg8::StaticOrder, true, true>(lds, g, S, E); }
    GRID_SYNC();

    NEWPHASE();
    { int tid7 = threadIdx.x; asm volatile("" : "+v"(tid7)); const int lane7 = tid7 & 63;
      for (int m = gw; m < NTOK; m += 4 * NGW) rms_rows_bf16_to_bf16<4>(H1B, g_ffn, XN, m, NGW, lane7); }
    GRID_SYNC();

    NEWPHASE();
    { pg8::Gemm g{XN, WGU, NTOK, 2 * DFF, DM}; pg8::StaticOrder S; S.init(NTOK, 2 * DFF, G, bx);
      pg8::Epi<pg8::M_SWIGLU> E{ACT, DFF, nullptr, 0, nullptr, nullptr, 1.f, nullptr, 0, 0.f};
      pg8::gemm_phase<pg8::Epi<pg8::M_SWIGLU>, pg8::StaticOrder, true, true>(lds, g, S, E); }
    GRID_SYNC();

    NEWPHASE();
    { pg8::Gemm g{ACT, WDN, NTOK, 1024, DFF}; pg8::StaticOrder S; S.init(NTOK, 1024, G, bx);
      pg8::Epi<pg8::M_RES2> E{H2B, 1024, H1B, 1024, nullptr, nullptr, 1.f, nullptr, 0, 0.f};
      pg8::gemm_phase<pg8::Epi<pg8::M_RES2>, pg8::StaticOrder, true, true>(lds, g, S, E); }
    GRID_SYNC();

    NEWPHASE();
    { pg8::Gemm g{PB, WPP, NTOK, 1024, PLE}; pg8::StaticOrder S; S.init(NTOK, 1024, G, bx);
      pg8::Epi<pg8::M_SCALE> E{EP, 1024, nullptr, 0, nullptr, nullptr, 1.f, nullptr, 0, 0.f};
      pg8::gemm_phase<pg8::Epi<pg8::M_SCALE>, pg8::StaticOrder, false, true>(lds, g, S, E); }
    { pg8::Gemm g{H2B, WPG, NTOK, 1024, 1024}; pg8::StaticOrder S; S.init(NTOK, 1024, G, bx);
      pg8::Epi<pg8::M_SIG> E{GS, 1024, nullptr, 0, nullptr, nullptr, 1.f, nullptr, 0, 0.f};
      pg8::gemm_phase<pg8::Epi<pg8::M_SIG>, pg8::StaticOrder, true, true>(lds, g, S, E); }
    GRID_SYNC();

    NEWPHASE();
    int tid11 = threadIdx.x; asm volatile("" : "+v"(tid11)); const int lane11 = tid11 & 63;
    for (int m0 = gw; m0 < NTOK; m0 += 2 * NGW) {
        f32x4 v[2][4], e[2][4], gsv[2][4]; float se[2], s3[2];
#pragma unroll
        for (int r = 0; r < 2; ++r) { const size_t m = (size_t)(m0 + r * NGW);
            const v2u* hr = (const v2u*)(H2B + m * DM) + lane11; const v2u* er = (const v2u*)(EP + m * DM) + lane11; const v2u* sr = (const v2u*)(GS + m * DM) + lane11;
#pragma unroll
            for (int j = 0; j < 4; ++j) { const v2u wh = __builtin_nontemporal_load(hr + 64 * j); v[r][j] = (f32x4){pg8::bf_lo(wh.x), pg8::bf_hi(wh.x), pg8::bf_lo(wh.y), pg8::bf_hi(wh.y)}; const v2u w = __builtin_nontemporal_load(er + 64 * j); const v2u w2 = __builtin_nontemporal_load(sr + 64 * j);
                e[r][j] = (f32x4){pg8::bf_lo(w.x), pg8::bf_hi(w.x), pg8::bf_lo(w.y), pg8::bf_hi(w.y)}; gsv[r][j] = (f32x4){pg8::bf_lo(w2.x), pg8::bf_hi(w2.x), pg8::bf_lo(w2.y), pg8::bf_hi(w2.y)}; } }
        f32x4 gp4[4], gf4[4];
#pragma unroll
        for (int j = 0; j < 4; ++j) { gp4[j] = ((const f32x4*)g_ple + lane11)[64 * j]; gf4[j] = ((const f32x4*)g_final + lane11)[64 * j]; }
#pragma unroll
        for (int r = 0; r < 2; ++r) { se[r] = 0.f;
#pragma unroll
            for (int j = 0; j < 4; ++j) se[r] += (e[r][j].x * e[r][j].x + e[r][j].y * e[r][j].y) + (e[r][j].z * e[r][j].z + e[r][j].w * e[r][j].w); }
#pragma unroll
        for (int o = 1; o < 64; o <<= 1) { se[0] += __shfl_xor(se[0], o); se[1] += __shfl_xor(se[1], o); }
#pragma unroll
        for (int r = 0; r < 2; ++r) { const float rse = 1.0f / sqrtf(se[r] * (1.f / DM) + EPS); s3[r] = 0.f;
#pragma unroll
            for (int j = 0; j < 4; ++j) { v[r][j] = v[r][j] + gsv[r][j] * (e[r][j] * rse * gp4[j]); s3[r] += (v[r][j].x * v[r][j].x + v[r][j].y * v[r][j].y) + (v[r][j].z * v[r][j].z + v[r][j].w * v[r][j].w); } }
#pragma unroll
        for (int o = 1; o < 64; o <<= 1) { s3[0] += __shfl_xor(s3[0], o); s3[1] += __shfl_xor(s3[1], o); }
#pragma unroll
        for (int r = 0; r < 2; ++r) { const float rs3 = 1.0f / sqrtf(s3[r] * (1.f / DM) + EPS); f32x4* hw = (f32x4*)(H + (size_t)(m0 + r * NGW) * DM) + lane11;
#pragma unroll
            for (int j = 0; j < 4; ++j) __builtin_nontemporal_store(v[r][j] * rs3 * gf4[j], hw + 64 * j); }
    }
}

#undef WIN
#undef WQB
#undef WKVB
#undef WBRA
#undef WBRB
#undef WOUT
#undef WGU
#undef WDN
#undef WPG
#undef WPP
#undef SSQ
#undef SSKV
#undef COS
#undef SIN
#undef KPE
#undef PB
#undef XN
#undef CQN
#undef CKVN
#undef OA
#undef OB
#undef PROJ
#undef ACT
#undef EP
#undef GS
#undef H1B
#undef Qb
#undef KVb
#undef MERGED
#undef H2B
#undef NEWPHASE
extern "C" void kernel_launch(void* const* d_in, const int* in_sizes, int n_in, void* d_out, int out_size, void* d_ws, size_t ws_size, hipStream_t stream) {
    static int grid = 0;
    if (grid == 0) {
        if (n_in != 20 || out_size != NTOK * DM || ws_size < WS_END) { fprintf(stderr, "kernel_launch: unexpected shapes (n_in %d out %d ws %zu)\n", n_in, out_size, ws_size); grid = -1; return; }
        int dev = 0, cus = 0, per_cu = 0;
        if (hipGetDevice(&dev) != hipSuccess || hipDeviceGetAttribute(&cus, hipDeviceAttributeMultiprocessorCount, dev) != hipSuccess) { grid = -1; return; }
        if (hipFuncSetAttribute((const void*)fwd_megakernel, hipFuncAttributeMaxDynamicSharedMemorySize, LDS_BYTES) != hipSuccess) { fprintf(stderr, "kernel_launch: hipFuncSetAttribute failed\n"); grid = -1; return; }
        if (hipOccupancyMaxActiveBlocksPerMultiprocessor(&per_cu, (const void*)fwd_megakernel, NWAVES * 64, LDS_BYTES) != hipSuccess || per_cu < 1) { fprintf(stderr, "kernel_launch: occupancy query says %d\n", per_cu); per_cu = 1; }
        (void)hipGetLastError();
        grid = cus;
    }
    if (grid < 0) return;
    if (hipMemsetAsync(d_ws, 0, 65536, stream) != hipSuccess) { fprintf(stderr, "kernel_launch: memset failed\n"); return; }
    Args a{};
    for (int i = 0; i < 20; ++i) a.in[i] = d_in[i];
    a.out = (float*)d_out; a.ws = (unsigned char*)d_ws;
    void* kargs[] = {&a};
    hipError_t e = hipLaunchCooperativeKernel((const void*)fwd_megakernel, dim3(grid), dim3(NWAVES * 64), kargs, LDS_BYTES, stream);
    if (e != hipSuccess) fprintf(stderr, "kernel_launch: cooperative launch failed: %s (grid %d)\n", hipGetErrorString(e), grid);
}
```

```cpp
#include <hip/hip_runtime.h>
#include <hip/hip_cooperative_groups.h>
#include <cstdio>
#include <cstdint>
namespace cg = cooperative_groups;

constexpr int NB = 8, SEQ = 4096, DM = 1024, NTOK = NB * SEQ;
constexpr int PLE = 256, QRANK = 384, KVRANK = 256, ROPE = 32, NH = 8;
constexpr int DFF = 2816, DINP = 4352;
constexpr int C_CQ = 0, C_CKV = 384, C_KPE = 640, C_QSB = 768, C_KSB = 1280, C_VSB = 1792, C_GA = 2304, C_GB = 3328;
constexpr float EPS = 1e-6f;
constexpr float LOG2E = 1.4426950408889634f;
constexpr float MLA_C2 = 0.10206207261596575f * 1.4426950408889634f;

namespace pg8 {
#define PG8_LAS __attribute__((address_space(3)))
typedef unsigned short bf16_t;
typedef short bf16x8 __attribute__((ext_vector_type(8)));
typedef float f32x4 __attribute__((ext_vector_type(4)));
typedef unsigned u32x4 __attribute__((ext_vector_type(4)));
constexpr int BM = 256, BK = 64, HALF = 128, HTB = HALF * BK * 2  , STAGE_BYTES = 8 * HTB, NXCD = 8, WGM = 8;

__host__ __device__ __forceinline__ int lds_byte(int r, int c) { const int st = (r >> 4) * 2 + (c >> 5), rr = r & 15, cc = c & 31, ob = rr * 64 + cc * 2; return st * 1024 + (ob ^ (((ob >> 9) & 1) << 5)); }
__host__ __device__ __forceinline__ void stage_rc(int b, int& R, int& C) { const int st = b / 1024, sb = b % 1024, swz = sb ^ (((sb >> 9) & 1) << 5); R = (st >> 1) * 16 + swz / 64; C = (st & 1) * 32 + (swz % 64) / 2; }
__host__ __device__ __forceinline__ int perm32(int rho) { const int n = rho >> 4, i = rho & 15; return 8 * (i >> 2) + 4 * n + (i & 3); }

struct Unit { int pm, pn, kh; };
struct Gemm { const bf16_t* A; const bf16_t* Bt; int M, N, K; int lda; int ldb; };

struct StaticOrder {
    int nM, nN, nwg, G, c;
    __host__ __device__ void init(int M, int N, int G_, int c_) { nM = M / BM; nN = N / BM; nwg = nM * nN; G = G_; c = c_; }
    __host__ __device__ bool next(int i, Unit& u) const {
        const long L = (long)i * G + c; if (L >= nwg) return false;
        int wgid = (int)L; { const int q = nwg / NXCD, r = nwg % NXCD, xcd = wgid % NXCD, off = wgid / NXCD; wgid = (xcd < r ? xcd * (q + 1) : r * (q + 1) + (xcd - r) * q) + off; }
        const int nig = WGM * nN, gid = wgid / nig, fm = gid * WGM, gsz = (nM - fm) < WGM ? (nM - fm) : WGM;
        u.pm = fm + ((wgid % nig) % gsz); u.pn = (wgid % nig) / gsz; return true;
    }
    __device__ __forceinline__ void a_ready(const Unit&) const {}
    __device__ __forceinline__ void done(const Unit&) const {}
};

typedef float f32x2_c __attribute__((ext_vector_type(2))); typedef __bf16 bf16x2_c __attribute__((ext_vector_type(2)));
__device__ __forceinline__ unsigned cvt_pk_bf16(float lo, float hi) { f32x2_c v = {lo, hi}; bf16x2_c b = __builtin_convertvector(v, bf16x2_c); return __builtin_bit_cast(unsigned, b); }
__device__ __forceinline__ float bf_lo(unsigned w) { return __uint_as_float(w << 16); }
__device__ __forceinline__ float bf_hi(unsigned w) { return __uint_as_float(w & 0xffff0000u); }
__device__ __forceinline__ float sigmoidf_fast(float v) { return __builtin_amdgcn_rcpf(1.0f + __builtin_amdgcn_exp2f(-v * 1.4426950408889634f)); }
__device__ __forceinline__ u32x4 pack8(const f32x4& a, const f32x4& b) { u32x4 w; w.x = cvt_pk_bf16(a[0], a[1]); w.y = cvt_pk_bf16(a[2], a[3]); w.z = cvt_pk_bf16(b[0], b[1]); w.w = cvt_pk_bf16(b[2], b[3]); return w; }
__device__ __forceinline__ void unpack8(const u32x4& w, f32x4& a, f32x4& b) { a = (f32x4){bf_lo(w.x), bf_hi(w.x), bf_lo(w.y), bf_hi(w.y)}; b = (f32x4){bf_lo(w.z), bf_hi(w.z), bf_lo(w.w), bf_hi(w.w)}; }

enum EpiMode { M_GATEF = 9, M_SCALER = 8, M_PROJ = 0, M_SCALE = 1, M_SIG = 2, M_GATE1 = 3, M_GATE2 = 4, M_RES = 5, M_RES2 = 6, M_SWIGLU = 7 };
template <int MODE> struct Epi {
    static constexpr bool PERM = true, AFTER_DRAIN = false, HAS_MID = (MODE == M_GATEF);
    __device__ __forceinline__ void mid(f32x4 (&acc)[2][2][4][2], const Unit& u, int wr, int wc, int fr, int fq) const {
        const unsigned lane_off = (unsigned)(((wr * 64 + fr) * ldg + wc * 32 + 8 * fq) * 2);
#pragma unroll
        for (int ai = 0; ai < 2; ++ai)
#pragma unroll
            for (int m = 0; m < 4; ++m) {
#pragma unroll
                for (int bj = 0; bj < 2; ++bj) { const size_t uni = ((size_t)(u.pm * BM + ai * HALF + m * 16) * ldg + 256 * (2 * u.pn + bj)) * 2;
                    f32x4 a, b; unpack8(*(const u32x4*)((const char*)G + uni + lane_off), a, b);
                    acc[ai][bj][m][0] = acc[ai][bj][m][0] * a; acc[ai][bj][m][1] = acc[ai][bj][m][1] * b; }
                asm volatile("" ::: "memory"); }
    }
    bf16_t* O; int ldo;
    const bf16_t* G; int ldg;
    const float* X; float* H;
    float scale;
    float* SQ;
    int np; float inv_n;
    __device__ __forceinline__ void operator()(const f32x4 (&acc)[2][2][4][2], const Unit& u, int wr, int wc, int fr, int fq) const {
        const int row0 = u.pm * BM + wr * 64 + fr;
#pragma unroll
        for (int ai = 0; ai < 2; ++ai)
#pragma unroll
            for (int m = 0; m < 4; ++m) {
                const size_t row = (size_t)(row0 + ai * HALF + m * 16);
                if constexpr (MODE == M_SWIGLU) {
                    const int col = u.pn * HALF + wc * 32 + 8 * fq;
                    f32x4 g0 = acc[ai][0][m][0], g1 = acc[ai][0][m][1]; const f32x4 u0 = acc[ai][1][m][0], u1 = acc[ai][1][m][1];
#pragma unroll
                    for (int i = 0; i < 4; ++i) { g0[i] = g0[i] * sigmoidf_fast(g0[i]) * u0[i]; g1[i] = g1[i] * sigmoidf_fast(g1[i]) * u1[i]; }
                    *(u32x4*)(O + row * ldo + col) = pack8(g0, g1);
                } else {
                    float rsc = scale;
                    if constexpr (MODE == M_SCALER) { float t = 0.f;
#pragma unroll
                        for (int k = 0; k < 3; ++k) if (4 * k < np) { const f32x4 pz = *(const f32x4*)(SQ + row * np + 4 * k); t += (pz[0] + pz[1]) + (pz[2] + pz[3]); }
                        rsc = scale / sqrtf(t * inv_n + 1e-6f); }
#pragma unroll
                    for (int bj = 0; bj < 2; ++bj) {
                        const int col = u.pn * BM + bj * HALF + wc * 32 + 8 * fq;
                        f32x4 v0 = acc[ai][bj][m][0], v1 = acc[ai][bj][m][1];
                        if constexpr (MODE == M_PROJ) {
                            if (u.pn <= 2) { unsigned char* wsb = (unsigned char*)SQ; float* SQq = (float*)(wsb + 37u * 1048576u); float* SKV = (float*)(wsb + 46u * 1048576u);
                                const float* CS = (const float*)(wsb + 40u * 1048576u); const float* SN = (const float*)(wsb + 42u * 1048576u); bf16_t* KP = (bf16_t*)(wsb + 44u * 1048576u);
                                if (!(u.pn == 2 && bj == 1)) {
                                    float q = (v0[0] * v0[0] + v0[1] * v0[1]) + (v0[2] * v0[2] + v0[3] * v0[3]) + (v1[0] * v1[0] + v1[1] * v1[1]) + (v1[2] * v1[2] + v1[3] * v1[3]);
                                    q += __shfl_xor(q, 16); q += __shfl_xor(q, 32);
                                    if (fq == 0) { if (u.pn == 0) SQq[row * 12 + bj * 4 + wc] = q; else if (u.pn == 1 && bj == 0) SQq[row * 12 + 8 + wc] = q; else if (u.pn == 1) SKV[row * 8 + wc] = q; else SKV[row * 8 + 4 + wc] = q; }
                                } else if (wc == 0) {
                                    const int j0 = 8 * (fq & 1); f32x4 r0, r1;
                                    { const f32x4 c = *(const f32x4*)(CS + row * 16 + j0), sn = *(const f32x4*)(SN + row * 16 + j0);
#pragma unroll
                                      for (int i = 0; i < 4; ++i) { const float xp = __shfl_xor(v0[i], 32); r0[i] = fq < 2 ? v0[i] * c[i] - xp * sn[i] : xp * sn[i] + v0[i] * c[i]; } }
                                    { const f32x4 c = *(const f32x4*)(CS + row * 16 + j0 + 4), sn = *(const f32x4*)(SN + row * 16 + j0 + 4);
#pragma unroll
                                      for (int i = 0; i < 4; ++i) { const float xp = __shfl_xor(v1[i], 32); r1[i] = fq < 2 ? v1[i] * c[i] - xp * sn[i] : xp * sn[i] + v1[i] * c[i]; } }
                                    *(u32x4*)(KP + row * 32 + 8 * fq) = pack8(r0, r1);
                                }
                            }
                            if (u.pn >= 9) {
                                if (bj == 0) { f32x4 a0 = acc[ai][0][m][0], a1 = acc[ai][0][m][1], b0 = acc[ai][1][m][0], b1 = acc[ai][1][m][1];
#pragma unroll
                                    for (int i = 0; i < 4; ++i) { const float sb0 = __builtin_fmaxf(sigmoidf_fast(b0[i]), 1e-30f), sb1 = __builtin_fmaxf(sigmoidf_fast(b1[i]), 1e-30f);
                                        a0[i] = sigmoidf_fast(a0[i]) * __builtin_amdgcn_rcpf(sb0); a1[i] = sigmoidf_fast(a1[i]) * __builtin_amdgcn_rcpf(sb1); b0[i] = sb0; b1[i] = sb1; }
                                    *(u32x4*)(O + row * ldo + col) = pack8(a0, a1); *(u32x4*)(O + row * ldo + col + HALF) = pack8(b0, b1); }
                            } else { if (u.pn == 3 || u.pn == 4) { v0 = v0 * (0.125f * 1.4426950408889634f); v1 = v1 * (0.125f * 1.4426950408889634f); }
                                *(u32x4*)(O + row * ldo + col) = pack8(v0, v1); }
                        } else if constexpr (MODE == M_GATEF) {
                            const unsigned lane_off = (unsigned)(((wr * 64 + fr) * ldg + wc * 32 + 8 * fq) * 2);
                            const size_t uni = ((size_t)(u.pm * BM + ai * HALF + m * 16) * ldg + 256 * (2 * u.pn + bj) + HALF) * 2;
                            f32x4 a, b; unpack8(*(const u32x4*)((const char*)G + uni + lane_off), a, b);
                            *(u32x4*)(O + row * ldo + col) = pack8(v0 * a, v1 * b);
                        } else if constexpr (MODE == M_SCALER) {
                            v0 = v0 * rsc; v1 = v1 * rsc;
                            *(u32x4*)(O + row * ldo + col) = pack8(v0, v1);
                        } else if constexpr (MODE == M_SCALE) {
                            v0 = v0 * scale; v1 = v1 * scale;
                            *(u32x4*)(O + row * ldo + col) = pack8(v0, v1);
                        } else if constexpr (MODE == M_SIG) {
#pragma unroll
                            for (int i = 0; i < 4; ++i) { v0[i] = sigmoidf_fast(v0[i]); v1[i] = sigmoidf_fast(v1[i]); }
                            *(u32x4*)(O + row * ldo + col) = pack8(v0, v1);
                        } else if constexpr (MODE == M_GATE1) {
                            f32x4 a, b; unpack8(*(const u32x4*)(G + row * ldg + col), a, b);
                            v0 = v0 * a; v1 = v1 * b;
                            *(u32x4*)(O + row * ldo + col) = pack8(v0, v1);
                        } else if constexpr (MODE == M_GATE2) {
                            f32x4 a, b, c, d; unpack8(*(const u32x4*)(G + row * ldg + col), a, b); unpack8(*(const u32x4*)(O + row * ldo + col), c, d);
                            v0 = c + v0 * a; v1 = d + v1 * b;
                            *(u32x4*)(O + row * ldo + col) = pack8(v0, v1);
                        } else if constexpr (MODE == M_RES) {
                            const f32x4 x0 = *(const f32x4*)(X + row * DM + col), x1 = *(const f32x4*)(X + row * DM + col + 4);
                            v0 = x0 + v0; v1 = x1 + v1;
                            *(u32x4*)(O + row * ldo + col) = pack8(v0, v1);
                        } else if constexpr (MODE == M_RES2) {
                            f32x4 x0, x1; unpack8(*(const u32x4*)(G + row * ldg + col), x0, x1);
                            v0 = x0 + v0; v1 = x1 + v1;
                            *(u32x4*)(O + row * ldo + col) = pack8(v0, v1);
                        }
                    }
                }
                if (m & 1) asm volatile("" ::: "memory");
            }
    }
};

struct SplitOrder {
    StaticOrder base;
    __device__ bool next(int i, Unit& u) const { const bool ok = base.next(i >> 1, u); u.kh = i & 1; return ok; }
    __device__ __forceinline__ void a_ready(const Unit&) const {}
    __device__ __forceinline__ void done(const Unit&) const {}
};

template <class Epi, class Sched, bool ALIGN_EPI = false, bool SP2 = false>
__device__ __forceinline__ void gemm_phase(PG8_LAS unsigned char* lds, const Gemm g, const Sched& S, const Epi& E) {
    int tid_ = threadIdx.x; asm volatile("" : "+v"(tid_));
    const int tid = tid_, wid = __builtin_amdgcn_readfirstlane(tid >> 6), lane = tid & 63, wr = wid >> 2, wc = wid & 3, fr = lane & 15, fq = lane >> 4;
    const int K = g.K, nt = K / BK, lda = g.lda ? g.lda : g.K, ldb = g.ldb ? g.ldb : g.K;
    unsigned voffA[2], voffB[2];
#pragma unroll
    for (int i = 0; i < 2; ++i) { int R, C; stage_rc(tid * 16 + i * 8192, R, C); const int Rb = Epi::PERM ? ((R & ~31) + perm32(R & 31)) : R;
        voffA[i] = (unsigned)(R * lda + C) * 2u; voffB[i] = (unsigned)(Rb * ldb + C) * 2u; }
    const size_t kstep = (size_t)(BK * 2);
    const size_t hstep = (size_t)HALF * ldb * 2;
    const size_t tstep = 2 * hstep;
    const size_t hstepA = (size_t)HALF * lda * 2, tstepA = 2 * hstepA;
    const unsigned ldsw = (unsigned)wid * 1024u;
    const int aoff = lds_byte(wr * 64 + fr, fq * 8), boff = lds_byte(wc * 32 + fr, fq * 8);
#define PG8_SA(b, h) (((b) * 2 + (h)) * HTB)
#define PG8_SB(b, h) ((4 + (b) * 2 + (h)) * HTB)
#define PG8_STAGE(bufoff, gbase, voff) do { _Pragma("unroll") for (int _i = 0; _i < 2; ++_i) \
        __builtin_amdgcn_global_load_lds((const unsigned*)((const char*)(gbase) + (voff)[_i]), (PG8_LAS unsigned*)(lds + (bufoff) + ldsw + _i * 8192), 16, 0, 0); } while (0)
#define PG8_LDA(dst, b, h) do { _Pragma("unroll") for (int m = 0; m < 4; ++m) _Pragma("unroll") for (int k = 0; k < 2; ++k) dst[m][k] = *(const PG8_LAS bf16x8*)(lds + PG8_SA(b, h) + aoff + m * 2048 + k * 1024); } while (0)
#define PG8_LDB(dst, b, h) do { _Pragma("unroll") for (int n = 0; n < 2; ++n) _Pragma("unroll") for (int k = 0; k < 2; ++k) dst[n][k] = *(const PG8_LAS bf16x8*)(lds + PG8_SB(b, h) + boff + n * 2048 + k * 1024); } while (0)
#define PG8_MMA(ai, bj, At, Bt) do { __builtin_amdgcn_s_setprio(1); _Pragma("unroll") for (int m = 0; m < 4; ++m) _Pragma("unroll") for (int n = 0; n < 2; ++n) _Pragma("unroll") for (int k = 0; k < 2; ++k) \
        acc[ai][bj][m][n] = __builtin_amdgcn_mfma_f32_16x16x32_bf16(Bt[n][k], At[m][k], acc[ai][bj][m][n], 0, 0, 0); __builtin_amdgcn_s_setprio(0); } while (0)
#define PG8_WAIT_V(n) asm volatile("s_waitcnt vmcnt(" #n ")" ::: "memory")
#define PG8_WAIT_L(n) asm volatile("s_waitcnt lgkmcnt(" #n ")" ::: "memory")
#define PG8_BAR __builtin_amdgcn_s_barrier()
#define PG8_SCHED __builtin_amdgcn_sched_barrier(0)
    Unit cur, nxt; int ui = 0;
    if (!S.next(0, cur)) return;
    f32x4 acc[2][2][4][2];
    bf16x8 At[4][2], B0[2][2], B1[2][2];
    const size_t khb = Epi::HAS_MID ? (size_t)K * 2 : 0;
    const char* cA = (const char*)g.A + (size_t)cur.pm * tstepA + (Epi::HAS_MID ? cur.kh * khb : 0); const char* cB = (const char*)g.Bt + (size_t)cur.pn * tstep + (Epi::HAS_MID ? cur.kh * khb : 0);
    S.a_ready(cur);
    if constexpr (SP2) {
        PG8_STAGE(PG8_SB(0, 0), cB, voffB); PG8_STAGE(PG8_SB(0, 1), cB + hstep, voffB); PG8_STAGE(PG8_SA(0, 0), cA, voffA); PG8_STAGE(PG8_SA(0, 1), cA + hstepA, voffA);
        if (wr == 1) PG8_BAR;
        PG8_WAIT_V(2); PG8_BAR;
        PG8_STAGE(PG8_SB(1, 0), cB + kstep, voffB); PG8_STAGE(PG8_SA(1, 0), cA + kstep, voffA); PG8_STAGE(PG8_SB(1, 1), cB + hstep + kstep, voffB);
        PG8_WAIT_V(6); PG8_BAR;
    } else {
        PG8_STAGE(PG8_SB(0, 0), cB, voffB); PG8_STAGE(PG8_SA(0, 0), cA, voffA); PG8_STAGE(PG8_SB(0, 1), cB + hstep, voffB); PG8_STAGE(PG8_SA(0, 1), cA + hstepA, voffA);
        if (wr == 1) PG8_BAR;
        PG8_WAIT_V(4); PG8_BAR;
        PG8_STAGE(PG8_SB(1, 0), cB + kstep, voffB); PG8_STAGE(PG8_SA(1, 0), cA + kstep, voffA); PG8_STAGE(PG8_SB(1, 1), cB + hstep + kstep, voffB);
        PG8_WAIT_V(6); PG8_BAR;
    }
#pragma unroll
    for (int a = 0; a < 2; ++a)
#pragma unroll
        for (int b = 0; b < 2; ++b)
#pragma unroll
            for (int m = 0; m < 4; ++m)
#pragma unroll
                for (int n = 0; n < 2; ++n) acc[a][b][m][n] = (f32x4){0.f, 0.f, 0.f, 0.f};
    for (;;) {
        const bool has_next = S.next(ui + 1, nxt);
        const char* nA = has_next ? (const char*)g.A + (size_t)nxt.pm * tstepA + (Epi::HAS_MID ? nxt.kh * khb : 0) : cA; const char* nB = has_next ? (const char*)g.Bt + (size_t)nxt.pn * tstep + (Epi::HAS_MID ? nxt.kh * khb : 0) : cB;
        for (int t = 0; t < nt; t += 2) {
            const bool last = (t == nt - 2);
            const char* a1 = cA + (size_t)(t + 1) * kstep;
            const char* a2 = last ? nA : cA + (size_t)(t + 2) * kstep; const char* b2 = last ? nB : cB + (size_t)(t + 2) * kstep;
            const char* a3 = a2 + kstep; const char* b3 = b2 + kstep;
            if (last && has_next) S.a_ready(nxt);
            if constexpr (SP2) {
            PG8_LDB(B0, 0, 0); PG8_LDB(B1, 0, 1); PG8_SCHED; PG8_LDA(At, 0, 0); PG8_STAGE(PG8_SA(1, 1), a1 + hstepA, voffA);
            PG8_WAIT_V(8); PG8_WAIT_L(0); PG8_BAR; PG8_MMA(0, 0, At, B0); PG8_MMA(0, 1, At, B1); PG8_BAR; PG8_SCHED;
            PG8_LDA(At, 0, 1); PG8_STAGE(PG8_SB(0, 0), b2, voffB); PG8_STAGE(PG8_SB(0, 1), b2 + hstep, voffB); PG8_STAGE(PG8_SA(0, 0), a2, voffA);
            PG8_WAIT_V(8); PG8_WAIT_L(0); PG8_BAR; PG8_MMA(1, 0, At, B0); PG8_MMA(1, 1, At, B1); PG8_BAR; PG8_SCHED;
            PG8_LDB(B0, 1, 0); PG8_LDB(B1, 1, 1); PG8_SCHED; PG8_LDA(At, 1, 0); PG8_STAGE(PG8_SA(0, 1), a2 + hstepA, voffA);
            PG8_WAIT_V(8); PG8_WAIT_L(0); PG8_BAR; PG8_MMA(0, 0, At, B0); PG8_MMA(0, 1, At, B1); PG8_BAR; PG8_SCHED;
            PG8_LDA(At, 1, 1); PG8_STAGE(PG8_SB(1, 0), b3, voffB); PG8_STAGE(PG8_SB(1, 1), b3 + hstep, voffB); PG8_STAGE(PG8_SA(1, 0), a3, voffA);
            PG8_WAIT_V(8); PG8_WAIT_L(0); PG8_BAR; PG8_MMA(1, 0, At, B0); PG8_MMA(1, 1, At, B1); PG8_BAR; PG8_SCHED;
            } else {
            PG8_LDB(B0, 0, 0); PG8_SCHED; PG8_LDA(At, 0, 0); PG8_STAGE(PG8_SA(1, 1), a1 + hstepA, voffA);
            PG8_WAIT_L(8); PG8_BAR; PG8_WAIT_L(0); PG8_MMA(0, 0, At, B0); PG8_BAR; PG8_SCHED;
            PG8_LDB(B1, 0, 1); PG8_STAGE(PG8_SB(0, 0), b2, voffB);
            PG8_BAR; PG8_WAIT_L(0); PG8_MMA(0, 1, At, B1); PG8_BAR;
            PG8_LDA(At, 0, 1); PG8_STAGE(PG8_SA(0, 0), a2, voffA);
            PG8_BAR; PG8_WAIT_L(0); PG8_MMA(1, 0, At, B0); PG8_BAR; PG8_SCHED;
            PG8_STAGE(PG8_SB(0, 1), b2 + hstep, voffB);
            PG8_WAIT_V(6); PG8_BAR; PG8_MMA(1, 1, At, B1); PG8_BAR;
            PG8_LDB(B0, 1, 0); PG8_SCHED; PG8_LDA(At, 1, 0); PG8_STAGE(PG8_SA(0, 1), a2 + hstepA, voffA);
            PG8_WAIT_L(8); PG8_BAR; PG8_WAIT_L(0); PG8_MMA(0, 0, At, B0); PG8_BAR; PG8_SCHED;
            PG8_LDB(B1, 1, 1); PG8_STAGE(PG8_SB(1, 0), b3, voffB);
            PG8_BAR; PG8_WAIT_L(0); PG8_MMA(0, 1, At, B1); PG8_BAR;
            PG8_LDA(At, 1, 1); PG8_STAGE(PG8_SA(1, 0), a3, voffA);
            PG8_BAR; PG8_WAIT_L(0); PG8_MMA(1, 0, At, B0); PG8_BAR; PG8_SCHED;
            PG8_STAGE(PG8_SB(1, 1), b3 + hstep, voffB);
            PG8_WAIT_V(6); PG8_BAR; PG8_MMA(1, 1, At, B1); PG8_BAR;
            }
        }
        if constexpr (ALIGN_EPI) { if (wr == 0) PG8_BAR; }
        bool keep_acc = false;
        if constexpr (!Epi::AFTER_DRAIN) {
            if constexpr (Epi::HAS_MID) { if (cur.kh == 0) { E.mid(acc, cur, wr, wc, fr, fq); keep_acc = true; } else E(acc, cur, wr, wc, fr, fq); }
            else E(acc, cur, wr, wc, fr, fq);
            S.done(cur); }
        if (!has_next) break;
        if (!keep_acc)
#pragma unroll
        for (int a = 0; a < 2; ++a)
#pragma unroll
            for (int b = 0; b < 2; ++b)
#pragma unroll
                for (int m = 0; m < 4; ++m)
#pragma unroll
                    for (int n = 0; n < 2; ++n) acc[a][b][m][n] = (f32x4){0.f, 0.f, 0.f, 0.f};
        cur = nxt; cA = nA; cB = nB; ++ui;
        if constexpr (ALIGN_EPI) { if (wr == 1) PG8_BAR; }
    }
    PG8_WAIT_V(0);
    if constexpr (!ALIGN_EPI) { if (wr == 0) PG8_BAR; }
    PG8_BAR;
    if constexpr (Epi::AFTER_DRAIN) { E.fused(acc, cur, wr, wc, fr, fq, lds, wid, lane); S.done(cur); }
#undef PG8_SA
#undef PG8_SB
#undef PG8_STAGE
#undef PG8_LDA
#undef PG8_LDB
#undef PG8_MMA
#undef PG8_WAIT_V
#undef PG8_WAIT_L
#undef PG8_BAR
#undef PG8_SCHED
}
}
namespace att {
#define ALAS __attribute__((address_space(3)))
typedef unsigned short bf16_t;
typedef ALAS char* lptr;
typedef ALAS const char* lcptr;
using bf16x8 = __attribute__((ext_vector_type(8))) short;
using s16x4 = __attribute__((ext_vector_type(4))) short;
using f32x16 = __attribute__((ext_vector_type(16))) float;
using f32x4 = __attribute__((ext_vector_type(4))) float;
using u32x4 = __attribute__((ext_vector_type(4))) unsigned;
constexpr int QB = 256, KVB = 64;
constexpr int KSLOT = 12288, VSLOT = 8192;
constexpr int L_K = 0, L_V = 3 * KSLOT, L_WS = L_V + 3 * VSLOT, L_FLAG = L_WS + 2048, L_OST = L_FLAG + 256, L_END = L_OST + 8 * 4096;
#define SBAR() __builtin_amdgcn_sched_barrier(0)
#define WAIT_BAR0() asm volatile("s_waitcnt vmcnt(0) lgkmcnt(0)\n\ts_barrier" ::: "memory")
__device__ __forceinline__ int crow(int r, int hi) { return (r & 3) + 8 * (r >> 2) + 4 * hi; }
__device__ __forceinline__ void glds(const void* g, lptr l) { __builtin_amdgcn_global_load_lds((const unsigned*)g, (ALAS unsigned*)l, 16, 0, 0); }
typedef float f32x2_t __attribute__((ext_vector_type(2))); typedef __bf16 bf16x2_t __attribute__((ext_vector_type(2)));
__device__ __forceinline__ unsigned cvtpk_s(float lo, float hi) { f32x2_t v = {lo, hi}; bf16x2_t b = __builtin_convertvector(v, bf16x2_t); return __builtin_bit_cast(unsigned, b); }
__device__ __forceinline__ float bfu_lo(unsigned w) { return __uint_as_float(w << 16); }
__device__ __forceinline__ float bfu_hi(unsigned w) { return __uint_as_float(w & 0xffff0000u); }

template <int ND> __device__ __forceinline__ void qkt(f32x16& p0, f32x16& p1, lcptr Kslot, const bf16x8* qr, const f32x16& c0, int r32, int hi) {
    lcptr kb = Kslot + hi * 1024 + r32 * 16;
#pragma unroll
    for (int d0 = 0; d0 < ND; ++d0) {
        const bf16x8 b0 = *(const ALAS bf16x8*)(kb + d0 * 2048);
        const bf16x8 b1 = *(const ALAS bf16x8*)(kb + d0 * 2048 + 512);
        if (d0 == 0) { p0 = __builtin_amdgcn_mfma_f32_32x32x16_bf16(b0, qr[0], c0, 0, 0, 0); p1 = __builtin_amdgcn_mfma_f32_32x32x16_bf16(b1, qr[0], c0, 0, 0, 0); }
        else { p0 = __builtin_amdgcn_mfma_f32_32x32x16_bf16(b0, qr[d0], p0, 0, 0, 0); p1 = __builtin_amdgcn_mfma_f32_32x32x16_bf16(b1, qr[d0], p1, 0, 0, 0); }
    }
}
__device__ __forceinline__ void pv(f32x16* o, int vb, bf16x8 pa0, bf16x8 pa1, bf16x8 pa2, bf16x8 pa3) {
#pragma unroll
    for (int d0 = 0; d0 < 2; ++d0) { s16x4 lo[4], hi[4];
#pragma unroll
        for (int ks = 0; ks < 4; ++ks) {
            asm volatile("ds_read_b64_tr_b16 %0,%1 offset:%c2" : "=&v"(lo[ks]) : "v"(vb), "i"(d0 * 4096 + ks * 1024) : "memory");
            asm volatile("ds_read_b64_tr_b16 %0,%1 offset:%c2" : "=&v"(hi[ks]) : "v"(vb), "i"(d0 * 4096 + ks * 1024 + 512) : "memory"); }
        asm volatile("s_waitcnt lgkmcnt(0)" ::: "memory"); SBAR();
#define PK(k) (bf16x8){lo[k][0], lo[k][1], lo[k][2], lo[k][3], hi[k][0], hi[k][1], hi[k][2], hi[k][3]}
        o[d0] = __builtin_amdgcn_mfma_f32_32x32x16_bf16(pa0, PK(0), o[d0], 0, 0, 0);
        o[d0] = __builtin_amdgcn_mfma_f32_32x32x16_bf16(pa1, PK(1), o[d0], 0, 0, 0);
        o[d0] = __builtin_amdgcn_mfma_f32_32x32x16_bf16(pa2, PK(2), o[d0], 0, 0, 0);
        o[d0] = __builtin_amdgcn_mfma_f32_32x32x16_bf16(pa3, PK(3), o[d0], 0, 0, 0);
#undef PK
    }
}
typedef short v4i16_t __attribute__((ext_vector_type(4)));
__device__ __forceinline__ s16x4 vtr(lcptr p) { return __builtin_bit_cast(s16x4, __builtin_amdgcn_ds_read_tr16_b64_v4i16((ALAS v4i16_t*)p)); }
__device__ __forceinline__ void pv2(f32x16* o, lcptr vp, bf16x8 pa0, bf16x8 pa1, bf16x8 pa2, bf16x8 pa3) {
#pragma unroll
    for (int d0 = 0; d0 < 2; ++d0) { bf16x8 vb[4];
#pragma unroll
        for (int ks = 0; ks < 4; ++ks) { const s16x4 lo = vtr(vp + d0 * 4096 + ks * 1024), hi = vtr(vp + d0 * 4096 + ks * 1024 + 512); vb[ks] = __builtin_shufflevector(lo, hi, 0, 1, 2, 3, 4, 5, 6, 7); }
        o[d0] = __builtin_amdgcn_mfma_f32_32x32x16_bf16(pa0, vb[0], o[d0], 0, 0, 0);
        o[d0] = __builtin_amdgcn_mfma_f32_32x32x16_bf16(pa1, vb[1], o[d0], 0, 0, 0);
        o[d0] = __builtin_amdgcn_mfma_f32_32x32x16_bf16(pa2, vb[2], o[d0], 0, 0, 0);
        o[d0] = __builtin_amdgcn_mfma_f32_32x32x16_bf16(pa3, vb[3], o[d0], 0, 0, 0);
    }
}
__device__ __forceinline__ float xhalf_max(float m) { auto rr = __builtin_amdgcn_permlane32_swap(__float_as_uint(m), __float_as_uint(m), false, false); return __builtin_fmaxf(__uint_as_float(rr[0]), __uint_as_float(rr[1])); }
__device__ __forceinline__ float xhalf_sum(float m) { auto rr = __builtin_amdgcn_permlane32_swap(__float_as_uint(m), __float_as_uint(m), false, false); return __uint_as_float(rr[0]) + __uint_as_float(rr[1]); }
#define PKW(P, B) cvtpk_s(P[B], P[B + 1])
__device__ __forceinline__ void store_o(const f32x16* o, const float* rs, lptr shm, int wid, int lane, int r32, int hi, bf16_t* Ow, int opitch) {
    ALAS bf16_t* stg = (ALAS bf16_t*)(shm + L_OST) + wid * 2048;
#pragma unroll
    for (int r = 0; r < 16; ++r) { const int orow = crow(r, hi);
#pragma unroll
        for (int d0 = 0; d0 < 2; ++d0) stg[orow * 64 + d0 * 32 + r32] = (bf16_t)(cvtpk_s(o[d0][r] * rs[r], 0.f) & 0xffffu); }
    asm volatile("s_waitcnt lgkmcnt(0)" ::: "memory");
#pragma unroll
    for (int i = 0; i < 4; ++i) { const int row = i * 8 + (lane >> 3), ch = lane & 7; const u32x4 v = *(const ALAS u32x4*)(stg + row * 64 + ch * 8); *(u32x4*)(Ow + (long)row * opitch + ch * 8) = v; }
}

__device__ __forceinline__ float max3f(float a, float b, float c) { float r; asm("v_max3_f32 %0, %1, %2, %3" : "=v"(r) : "v"(a), "v"(b), "v"(c)); return r; }
template <bool BAND, bool HAS_NEXT>
__device__ __forceinline__ void mla_step(f32x16& pc0, f32x16& pc1, f32x16& pn0, f32x16& pn1, f32x16* o, f32x16& negm, float& mhat, float& l_reg,
                                         lcptr Knext, int vb, const bf16x8* qr, ALAS float* wsf, int jb, int qrel, int r32, int hi) {
    if constexpr (BAND) { const int kb = 64 * jb + 4 * hi;
#pragma unroll
        for (int r = 0; r < 16; ++r) { const int kv = kb + (r & 3) + 8 * (r >> 2); if (kv > qrel) pc0[r] = -INFINITY; if (kv + 32 > qrel) pc1[r] = -INFINITY; } }
    float rm;
    if constexpr (!BAND) {
        float a = max3f(pc0[0], pc0[1], pc1[0]), b2 = max3f(pc0[2], pc0[3], pc1[1]); a = max3f(a, pc1[2], pc1[3]);
#pragma unroll
        for (int r = 4; r < 16; r += 4) { a = max3f(a, pc0[r], pc0[r + 1]); b2 = max3f(b2, pc0[r + 2], pc0[r + 3]); a = max3f(a, pc1[r], pc1[r + 1]); b2 = max3f(b2, pc1[r + 2], pc1[r + 3]); }
        rm = max3f(a, b2, b2);
    } else {
        rm = __builtin_fmaxf(pc0[0], pc1[0]);
#pragma unroll
        for (int r = 1; r < 16; ++r) rm = __builtin_fmaxf(rm, __builtin_fmaxf(pc0[r], pc1[r]));
    }
    rm = xhalf_max(rm);
    if (__builtin_expect(__any(rm > 8.0f), 0)) {
        const float dl = __builtin_fmaxf(rm, 0.f); mhat += dl;
#pragma unroll
        for (int r = 0; r < 16; ++r) { pc0[r] -= dl; pc1[r] -= dl; negm[r] = -mhat; }
        const float f = __builtin_amdgcn_exp2f(-dl); l_reg *= f; if (hi == 0) wsf[r32] = f;
        asm volatile("s_waitcnt lgkmcnt(0)" ::: "memory");
#pragma unroll
        for (int g = 0; g < 4; ++g) { const f32x4 fv = *(const ALAS f32x4*)(wsf + 8 * g + 4 * hi);
#pragma unroll
            for (int i = 0; i < 4; ++i) { o[0][4 * g + i] *= fv[i]; o[1][4 * g + i] *= fv[i]; } }
    }
    if constexpr (HAS_NEXT) qkt<6>(pn0, pn1, Knext, qr, negm, r32, hi);
    float sacc = 0.f;
#pragma unroll
    for (int r = 0; r < 16; ++r) { pc0[r] = __builtin_amdgcn_exp2f(pc0[r]); pc1[r] = __builtin_amdgcn_exp2f(pc1[r]); sacc += pc0[r] + pc1[r]; }
    l_reg += sacc;
    const u32x4 pw0 = (u32x4){PKW(pc0, 0), PKW(pc0, 2), PKW(pc0, 4), PKW(pc0, 6)}, pw1 = (u32x4){PKW(pc0, 8), PKW(pc0, 10), PKW(pc0, 12), PKW(pc0, 14)};
    const u32x4 pw2 = (u32x4){PKW(pc1, 0), PKW(pc1, 2), PKW(pc1, 4), PKW(pc1, 6)}, pw3 = (u32x4){PKW(pc1, 8), PKW(pc1, 10), PKW(pc1, 12), PKW(pc1, 14)};
    if constexpr (HAS_NEXT) {
#pragma unroll
        for (int i = 0; i < 12; ++i) { __builtin_amdgcn_sched_group_barrier(0x008, 1, 0); __builtin_amdgcn_sched_group_barrier(0x002, 8, 0); }
    }
    pv2(o, (lcptr)(uintptr_t)(unsigned)vb, __builtin_bit_cast(bf16x8, pw0), __builtin_bit_cast(bf16x8, pw1), __builtin_bit_cast(bf16x8, pw2), __builtin_bit_cast(bf16x8, pw3));
}
__device__ __forceinline__ void mla_unit(int b, int h, int qb, const bf16_t* Q, const bf16_t* KV, const bf16_t* KPE, const float* COS, const float* SIN, bf16_t* OA, lptr shm) {
    int tid_ = threadIdx.x; asm volatile("" : "+v"(tid_));
    const int tid = tid_, lane = tid & 63, r32 = lane & 31, hi = lane >> 5; const int wid = __builtin_amdgcn_readfirstlane(tid >> 6);
    const long rowbase = (long)b * SEQ; const int q0 = qb * QB;
    const bf16_t* Qw = Q + (rowbase + q0 + wid * 32) * 768 + h * 96;
    const bf16_t* Kh = KV + rowbase * 1024 + h * 128; const bf16_t* Vh = Kh + 64;
    ALAS float* wsf = (ALAS float*)(shm + L_WS) + wid * 64;
    const bf16_t* ksrc = Kh + (long)lane * 1024 + wid * 8;
    const bf16_t* kpsrc = KPE + (rowbase + lane) * 32 + (wid & 3) * 8;
    const bf16_t* vsrc = Vh + (long)(16 * (wid & 3) + (lane >> 2)) * 1024 + (wid >> 2) * 32 + (lane & 3) * 8;
    const int vb0 = (int)(unsigned)(uintptr_t)(shm + L_V) + ((lane >> 4) & 1) * 32 + (lane & 3) * 8 + (4 * hi + ((lane & 15) >> 2)) * 64;
#define MLA_DMA(t, slot) do { glds(ksrc + (long)(t) * KVB * 1024, shm + L_K + (slot) * KSLOT + wid * 1024); \
        if (wid < 4) glds(kpsrc + (long)(t) * KVB * 32, shm + L_K + (slot) * KSLOT + 8192 + wid * 1024); \
        glds(vsrc + (long)(t) * KVB * 1024, shm + L_V + (slot) * VSLOT + wid * 1024); } while (0)
    const int NT = (q0 + QB) / KVB;
    const int Tw = NT - 3 + (wid >> 1);
    MLA_DMA(0, 0); MLA_DMA(1, 1);
    bf16x8 qr[6];
#pragma unroll
    for (int d0 = 0; d0 < 4; ++d0) qr[d0] = *(const bf16x8*)(Qw + (long)r32 * 768 + d0 * 16 + hi * 8);
    {
        const u32x4 x1 = *(const u32x4*)(Qw + (long)r32 * 768 + 64 + hi * 8), x2 = *(const u32x4*)(Qw + (long)r32 * 768 + 80 + hi * 8);
        const float* cp = COS + (rowbase + q0 + wid * 32 + r32) * 16 + hi * 8; const float* sp = SIN + (rowbase + q0 + wid * 32 + r32) * 16 + hi * 8;
        const f32x4 c0 = *(const f32x4*)cp, c1 = *(const f32x4*)(cp + 4), s0 = *(const f32x4*)sp, s1 = *(const f32x4*)(sp + 4);
        const float a[8] = {bfu_lo(x1.x), bfu_hi(x1.x), bfu_lo(x1.y), bfu_hi(x1.y), bfu_lo(x1.z), bfu_hi(x1.z), bfu_lo(x1.w), bfu_hi(x1.w)};
        const float bb[8] = {bfu_lo(x2.x), bfu_hi(x2.x), bfu_lo(x2.y), bfu_hi(x2.y), bfu_lo(x2.z), bfu_hi(x2.z), bfu_lo(x2.w), bfu_hi(x2.w)};
        const float cc[8] = {c0[0], c0[1], c0[2], c0[3], c1[0], c1[1], c1[2], c1[3]}, ss[8] = {s0[0], s0[1], s0[2], s0[3], s1[0], s1[1], s1[2], s1[3]};
        u32x4 o1, o2;
        o1.x = cvtpk_s(a[0] * cc[0] - bb[0] * ss[0], a[1] * cc[1] - bb[1] * ss[1]); o1.y = cvtpk_s(a[2] * cc[2] - bb[2] * ss[2], a[3] * cc[3] - bb[3] * ss[3]);
        o1.z = cvtpk_s(a[4] * cc[4] - bb[4] * ss[4], a[5] * cc[5] - bb[5] * ss[5]); o1.w = cvtpk_s(a[6] * cc[6] - bb[6] * ss[6], a[7] * cc[7] - bb[7] * ss[7]);
        o2.x = cvtpk_s(a[0] * ss[0] + bb[0] * cc[0], a[1] * ss[1] + bb[1] * cc[1]); o2.y = cvtpk_s(a[2] * ss[2] + bb[2] * cc[2], a[3] * ss[3] + bb[3] * cc[3]);
        o2.z = cvtpk_s(a[4] * ss[4] + bb[4] * cc[4], a[5] * ss[5] + bb[5] * cc[5]); o2.w = cvtpk_s(a[6] * ss[6] + bb[6] * cc[6], a[7] * ss[7] + bb[7] * cc[7]);
        qr[4] = __builtin_bit_cast(bf16x8, o1); qr[5] = __builtin_bit_cast(bf16x8, o2);
    }
    float mhat = 0.f, l_reg = 0.f; f32x16 o[2]; o[0] = f32x16{}; o[1] = f32x16{}; f32x16 negm = f32x16{};
    const int qrel = wid * 32 + r32;
    f32x16 pA0, pA1, pB0, pB1;
    WAIT_BAR0();
    MLA_DMA(2, 2);
    qkt<6>(pA0, pA1, (lcptr)(shm + L_K), qr, negm, r32, hi);
    if (NT == 4) { const int kb = 4 * hi;
#pragma unroll
        for (int r = 0; r < 16; ++r) { const int kv = kb + (r & 3) + 8 * (r >> 2); if (kv > qrel) pA0[r] = -INFINITY; if (kv + 32 > qrel) pA1[r] = -INFINITY; } }
    { float rm = __builtin_fmaxf(pA0[0], pA1[0]);
#pragma unroll
      for (int r = 1; r < 16; ++r) rm = __builtin_fmaxf(rm, __builtin_fmaxf(pA0[r], pA1[r]));
      rm = xhalf_max(rm); mhat = rm;
#pragma unroll
      for (int r = 0; r < 16; ++r) { pA0[r] -= rm; pA1[r] -= rm; negm[r] = -mhat; } }
    int s_cur = 0, s_nxt = 1, s_fre = 2;
#define MLA_SEAM(t_) do { if ((t_) > 0) { WAIT_BAR0(); if ((t_) + 2 < NT) MLA_DMA((t_) + 2, s_fre); } } while (0)
#define MLA_ROT() do { const int x_ = s_cur; s_cur = s_nxt; s_nxt = s_fre; s_fre = x_; } while (0)
    for (int t = 0; t < NT - 4; t += 2) {
        MLA_SEAM(t);
        mla_step<false, true>(pA0, pA1, pB0, pB1, o, negm, mhat, l_reg, (lcptr)(shm + L_K + s_nxt * KSLOT), vb0 + s_cur * VSLOT, qr, wsf, 0, qrel, r32, hi);
        MLA_ROT();
        MLA_SEAM(t + 1);
        mla_step<false, true>(pB0, pB1, pA0, pA1, o, negm, mhat, l_reg, (lcptr)(shm + L_K + s_nxt * KSLOT), vb0 + s_cur * VSLOT, qr, wsf, 0, qrel, r32, hi);
        MLA_ROT();
    }
    for (int t = NT - 4; t < NT; ++t) {
        MLA_SEAM(t);
        if (t < Tw) {
            if (t > NT - 4) qkt<6>(pA0, pA1, (lcptr)(shm + L_K + s_cur * KSLOT), qr, negm, r32, hi);
            mla_step<true, false>(pA0, pA1, pB0, pB1, o, negm, mhat, l_reg, (lcptr)(shm + L_K), vb0 + s_cur * VSLOT, qr, wsf, t - (NT - 4), qrel, r32, hi);
        }
        MLA_ROT();
    }
#undef MLA_SEAM
#undef MLA_ROT
#undef MLA_DMA
    l_reg = xhalf_sum(l_reg);
    if (hi == 0) wsf[32 + r32] = l_reg; asm volatile("s_waitcnt lgkmcnt(0)" ::: "memory");
    float rli[16];
#pragma unroll
    for (int r = 0; r < 16; ++r) rli[r] = __builtin_amdgcn_rcpf(wsf[32 + crow(r, hi)]);
    store_o(o, rli, shm, wid, lane, r32, hi, OA + (rowbase + q0 + wid * 32) * 1024 + h * 64, 1024);
    asm volatile("s_waitcnt lgkmcnt(0)\n\ts_barrier" ::: "memory");
}

__device__ __forceinline__ void sb_unit(int b, int h, int qb, const bf16_t* PROJ, bf16_t* OB, lptr shm) {
    int tid_ = threadIdx.x; asm volatile("" : "+v"(tid_));
    const int tid = tid_, lane = tid & 63, r32 = lane & 31, hi = lane >> 5; const int wid = __builtin_amdgcn_readfirstlane(tid >> 6);
    const long rowbase = (long)b * SEQ; const int q0 = qb * QB;
    const bf16_t* Qw = PROJ + (rowbase + q0 + wid * 32) * DINP + C_QSB + h * 64;
    const bf16_t* Kh = PROJ + rowbase * DINP + C_KSB + h * 64; const bf16_t* Vh = PROJ + rowbase * DINP + C_VSB + h * 64;
    const bf16_t* ksrc = Kh + (long)lane * DINP + wid * 8;
    const bf16_t* vsrc = Vh + (long)(16 * (wid & 3) + (lane >> 2)) * DINP + (wid >> 2) * 32 + (lane & 3) * 8;
    const int vb0 = (int)(unsigned)(uintptr_t)(shm + L_V) + ((lane >> 4) & 1) * 32 + (lane & 3) * 8 + (4 * hi + ((lane & 15) >> 2)) * 64;
    ALAS unsigned* flags = (ALAS unsigned*)(shm + L_FLAG);
#define SB_DMA(t, slot) do { glds(ksrc + (long)(t) * KVB * DINP, shm + L_K + (slot) * KSLOT + wid * 1024); \
        glds(vsrc + (long)(t) * KVB * DINP, shm + L_V + (slot) * VSLOT + wid * 1024); } while (0)
    const int NT = (q0 + QB) / KVB;
    int t = NT - 1;
    SB_DMA(t, 0);
    bf16x8 qr[4];
#pragma unroll
    for (int d0 = 0; d0 < 4; ++d0) qr[d0] = *(const bf16x8*)(Qw + (long)r32 * DINP + d0 * 16 + hi * 8);
    f32x16 o[2]; o[0] = f32x16{}; o[1] = f32x16{}; const f32x16 zero16 = f32x16{};
    float R = 1.0f;
    const int qrel = wid * 32 + r32;
    for (int i = 0;; ++i) {
        WAIT_BAR0();
        if (i > 0) { unsigned all = 1u;
#pragma unroll
            for (int w = 0; w < 8; ++w) all &= flags[((i - 1) & 1) * 8 + w];
            if (all) break; }
        if (t > 0) SB_DMA(t - 1, (i + 1) & 1);
        const int jb = t - (NT - 4);
        const bool skip = (jb >= 0 && 64 * jb >= 32 * wid + 31) || __all(R == 0.0f);
        if (!skip) {
            f32x16 z0, z1;
            qkt<4>(z0, z1, (lcptr)(shm + L_K + (i & 1) * KSLOT), qr, zero16, r32, hi);
            float M0[16], M1[16];
            if (jb >= 0) {
#pragma unroll
                for (int r = 0; r < 16; ++r) { const int kv = 64 * jb + crow(r, hi);
                    { const float om = __builtin_amdgcn_rcpf(1.0f + __builtin_amdgcn_exp2f(z0[r])); M0[r] = (kv >= qrel) ? 1.0f : om; }
                    { const float om = __builtin_amdgcn_rcpf(1.0f + __builtin_amdgcn_exp2f(z1[r])); M1[r] = (kv + 32 >= qrel) ? 1.0f : om; } }
            } else {
#pragma unroll
                for (int r = 0; r < 16; ++r) { M0[r] = __builtin_amdgcn_rcpf(1.0f + __builtin_amdgcn_exp2f(z0[r])); M1[r] = __builtin_amdgcn_rcpf(1.0f + __builtin_amdgcn_exp2f(z1[r])); }
            }
            float G[8], PG[8], ST[8], W0[16], W1[16];
            { float link = 0.f;
#pragma unroll
              for (int g = 0; g < 4; ++g) { float p = M0[4 * g]; asm volatile("" : "+v"(p) : "v"(link)); p *= M0[4 * g + 1]; p *= M0[4 * g + 2]; p *= M0[4 * g + 3]; G[g] = p; link = p;
                                            float q = M1[4 * g]; asm volatile("" : "+v"(q) : "v"(link)); q *= M1[4 * g + 1]; q *= M1[4 * g + 2]; q *= M1[4 * g + 3]; G[4 + g] = q; link = q; } }
#pragma unroll
            for (int j = 0; j < 8; ++j) PG[j] = __shfl_xor(G[j], 32);
            ST[7] = 1.0f;
#pragma unroll
            for (int j = 6; j >= 0; --j) ST[j] = ST[j + 1] * (G[j + 1] * PG[j + 1]);
            const float total = ST[0] * (G[0] * PG[0]);
            { float link = 0.f;
#pragma unroll
              for (int g = 0; g < 4; ++g) {
                { float after = R * ST[g] * (hi == 0 ? PG[g] : 1.0f); asm volatile("" : "+v"(after) : "v"(link));
#pragma unroll
                  for (int ii = 3; ii >= 0; --ii) { const float om = M0[4 * g + ii]; W0[4 * g + ii] = __builtin_fmaf(-after, om, after); after *= om; }
                  link = after; }
                { float after = R * ST[4 + g] * (hi == 0 ? PG[4 + g] : 1.0f); asm volatile("" : "+v"(after) : "v"(link));
#pragma unroll
                  for (int ii = 3; ii >= 0; --ii) { const float om = M1[4 * g + ii]; W1[4 * g + ii] = __builtin_fmaf(-after, om, after); after *= om; }
                  link = after; }
              } }
            R *= total;
            const u32x4 pw0 = (u32x4){PKW(W0, 0), PKW(W0, 2), PKW(W0, 4), PKW(W0, 6)}, pw1 = (u32x4){PKW(W0, 8), PKW(W0, 10), PKW(W0, 12), PKW(W0, 14)};
            const u32x4 pw2 = (u32x4){PKW(W1, 0), PKW(W1, 2), PKW(W1, 4), PKW(W1, 6)}, pw3 = (u32x4){PKW(W1, 8), PKW(W1, 10), PKW(W1, 12), PKW(W1, 14)};
            SBAR();
            pv2(o, (lcptr)(uintptr_t)(unsigned)(vb0 + (i & 1) * VSLOT), __builtin_bit_cast(bf16x8, pw0), __builtin_bit_cast(bf16x8, pw1), __builtin_bit_cast(bf16x8, pw2), __builtin_bit_cast(bf16x8, pw3));
        }
        const unsigned done_w = __all(R == 0.0f) ? 1u : 0u;
        if (lane == 0) flags[(i & 1) * 8 + wid] = done_w;
        if (t == 0) break;
        --t;
    }
#undef SB_DMA
    float one[16];
#pragma unroll
    for (int r = 0; r < 16; ++r) one[r] = 1.0f;
    store_o(o, one, shm, wid, lane, r32, hi, OB + (rowbase + q0 + wid * 32) * 1024 + 512 + h * 64, 1024);
    asm volatile("s_waitcnt lgkmcnt(0)\n\ts_barrier" ::: "memory");
}
#undef PKW
#undef SBAR
#undef WAIT_BAR0
}

#define GAS __attribute__((address_space(1)))
#define LAS __attribute__((address_space(3)))
typedef unsigned short bf16;
typedef unsigned v4u __attribute__((ext_vector_type(4)));
typedef unsigned v2u __attribute__((ext_vector_type(2)));
typedef float f32x4 __attribute__((ext_vector_type(4)));
constexpr int NWAVES = 8;
constexpr size_t MiB = 1u << 20;
constexpr size_t WS_WIN = 2 * MiB, WS_WQB = 11 * MiB, WS_WKVB = 12 * MiB, WS_WBRA = 13 * MiB, WS_WBRB = 14 * MiB, WS_WOUT = 15 * MiB, WS_WGU = 17 * MiB, WS_WDN = 28 * MiB, WS_WPG = 34 * MiB, WS_WPP = 36 * MiB;
constexpr size_t WS_COS = 40 * MiB, WS_SIN = 42 * MiB, WS_KPE = 44 * MiB, WS_PB = 48 * MiB;
constexpr size_t WS_XN = 64 * MiB;
constexpr size_t WS_CQN = 64 * MiB, WS_CKVN = 88 * MiB, WS_OA = 64 * MiB, WS_OB = 96 * MiB;
constexpr size_t WS_PROJ = 128 * MiB;
constexpr size_t WS_ACT = 128 * MiB, WS_EP = 304 * MiB, WS_GS = 368 * MiB;
constexpr size_t WS_Q = 400 * MiB, WS_KV = 448 * MiB;
constexpr size_t WS_MERGED = 448 * MiB, WS_H2B = 448 * MiB, WS_END = 512 * MiB;
static_assert(WS_PROJ + (size_t)NTOK * DINP * 2 <= WS_Q && WS_ACT + (size_t)NTOK * DFF * 2 <= WS_EP && WS_GS + (size_t)NTOK * DM * 2 <= WS_KV && WS_Q + (size_t)NTOK * 768 * 2 <= WS_KV, "ws map");
static_assert(WS_WIN + (size_t)DINP * DM * 2 <= WS_WQB && WS_WGU + (size_t)2 * DFF * DM * 2 <= WS_WDN && WS_WDN + (size_t)DFF * DM * 2 <= WS_WPG, "ws weights");
constexpr int LDS_BYTES = 131072 + 1024;
static_assert(att::L_END <= 131072, "attention LDS");

__device__ __forceinline__ unsigned f2bf(float f) { unsigned u = __builtin_bit_cast(unsigned, f); return (u + 0x7fffu + ((u >> 16) & 1u)) >> 16; }
__device__ __forceinline__ unsigned pk2(float lo, float hi) { return f2bf(lo) | (f2bf(hi) << 16); }
__device__ __forceinline__ float wave_sum(float v) {
#pragma unroll
    for (int o = 1; o < 64; o <<= 1) v += __shfl_xor(v, o);
    return v;
}
__device__ __forceinline__ int dest_row(int mode, int n0) {
    if (mode == 1) {
        if (n0 < 672) return n0;
        if (n0 < 2208) return n0 + 96;
        if (n0 < 3232) { const int j = n0 - 2208; return 2304 + 256 * (j >> 7) + (j & 127); }
        const int j = n0 - 3232; return 2304 + 256 * (j >> 7) + 128 + (j & 127);
    }
    if (mode == 2) return 256 * (n0 >> 7) + (n0 & 127);
    if (mode == 3) return 256 * (n0 >> 7) + 128 + (n0 & 127);
    return n0;
}
__device__ __forceinline__ void transpose_item(const float* W, int K, int N, bf16* WT, int mode, LAS float* scr, int item, int lane, const float* gk = nullptr, int ldk = 0, int koff = 0) {
    const int nblk = N / 32, kb = item / nblk, nb = item % nblk, k0 = 64 * kb, n0 = 32 * nb;
    const int dr = dest_row(mode, n0);
#pragma unroll 8
    for (int i = 0; i < 32; ++i) { const int kk = 2 * i + (lane >> 5); float w = __builtin_nontemporal_load(W + (size_t)(k0 + kk) * N + n0 + (lane & 31)); if (gk) w *= gk[k0 + kk]; scr[kk * 33 + (lane & 31)] = w; }
    asm volatile("s_waitcnt lgkmcnt(0)" ::: "memory");
    const int c = lane & 7;
#pragma unroll
    for (int j = 0; j < 4; ++j) { const int n = (lane >> 3) + 8 * j; const LAS float* s = scr + (8 * c) * 33 + n;
        v4u o; o.x = pk2(s[0 * 33], s[1 * 33]); o.y = pk2(s[2 * 33], s[3 * 33]); o.z = pk2(s[4 * 33], s[5 * 33]); o.w = pk2(s[6 * 33], s[7 * 33]);
        *(v4u*)(WT + (size_t)(dr + n) * (ldk ? ldk : K) + koff + k0 + 8 * c) = o; }
    asm volatile("s_waitcnt lgkmcnt(0)" ::: "memory");
}
template <int R> __device__ __forceinline__ void rms_rows_to_bf16(const float* src, const float* g, bf16* dst, int m0, int mstride, int lane) {
    f32x4 v[R][4]; float s[R];
#pragma unroll
    for (int r = 0; r < R; ++r) { const f32x4* xr = (const f32x4*)(src + (size_t)(m0 + r * mstride) * DM) + lane;
#pragma unroll
        for (int j = 0; j < 4; ++j) v[r][j] = xr[64 * j]; }
    f32x4 gg[4];
#pragma unroll
    for (int j = 0; j < 4; ++j) gg[j] = ((const f32x4*)g + lane)[64 * j];
#pragma unroll
    for (int r = 0; r < R; ++r) { s[r] = 0.f;
#pragma unroll
        for (int j = 0; j < 4; ++j) s[r] += (v[r][j].x * v[r][j].x + v[r][j].y * v[r][j].y) + (v[r][j].z * v[r][j].z + v[r][j].w * v[r][j].w); }
#pragma unroll
    for (int o = 1; o < 64; o <<= 1) {
#pragma unroll
        for (int r = 0; r < R; ++r) s[r] += __shfl_xor(s[r], o); }
#pragma unroll
    for (int r = 0; r < R; ++r) { const float rstd = 1.0f / sqrtf(s[r] * (1.f / DM) + EPS); v2u* o8 = (v2u*)(dst + (size_t)(m0 + r * mstride) * DM) + lane;
#pragma unroll
        for (int j = 0; j < 4; ++j) { v2u w; w.x = pk2(v[r][j].x * rstd * gg[j].x, v[r][j].y * rstd * gg[j].y); w.y = pk2(v[r][j].z * rstd * gg[j].z, v[r][j].w * rstd * gg[j].w); o8[64 * j] = w; } }
}
template <int R> __device__ __forceinline__ void rms_rows_bf16_to_bf16(const bf16* src, const float* g, bf16* dst, int m0, int mstride, int lane) {
    f32x4 v[R][4]; float s[R];
#pragma unroll
    for (int r = 0; r < R; ++r) { const v2u* xr = (const v2u*)(src + (size_t)(m0 + r * mstride) * DM) + lane;
#pragma unroll
        for (int j = 0; j < 4; ++j) { const v2u w = xr[64 * j]; v[r][j] = (f32x4){pg8::bf_lo(w.x), pg8::bf_hi(w.x), pg8::bf_lo(w.y), pg8::bf_hi(w.y)}; } }
    f32x4 gg[4];
#pragma unroll
    for (int j = 0; j < 4; ++j) gg[j] = ((const f32x4*)g + lane)[64 * j];
#pragma unroll
    for (int r = 0; r < R; ++r) { s[r] = 0.f;
#pragma unroll
        for (int j = 0; j < 4; ++j) s[r] += (v[r][j].x * v[r][j].x + v[r][j].y * v[r][j].y) + (v[r][j].z * v[r][j].z + v[r][j].w * v[r][j].w); }
#pragma unroll
    for (int o = 1; o < 64; o <<= 1) {
#pragma unroll
        for (int r = 0; r < R; ++r) s[r] += __shfl_xor(s[r], o); }
#pragma unroll
    for (int r = 0; r < R; ++r) { const float rstd = 1.0f / sqrtf(s[r] * (1.f / DM) + EPS); v2u* o8 = (v2u*)(dst + (size_t)(m0 + r * mstride) * DM) + lane;
#pragma unroll
        for (int j = 0; j < 4; ++j) { v2u w; w.x = pk2(v[r][j].x * rstd * gg[j].x, v[r][j].y * rstd * gg[j].y); w.y = pk2(v[r][j].z * rstd * gg[j].z, v[r][j].w * rstd * gg[j].w); o8[64 * j] = w; } }
}
__device__ __forceinline__ float inv_freq(int j) {
    const float b = (j & 2) ? ((j & 1) ? 0.17782794100389228f : 0.31622776601683794f) : ((j & 1) ? 0.5623413251903491f : 1.0f);
    const float s = (j & 8) ? ((j & 4) ? 0.001f : 0.01f) : ((j & 4) ? 0.1f : 1.0f);
    return b * s;
}


typedef unsigned gu32_t;
#define XB_TMO      128
#define XB_XCNT(j)  (256  + 64 * (j))
#define XB_XSUB(j)  (1280 + 64 * (j))
#define XB_XGEN(j)  (2304 + 64 * (j))
#define XB_TOP      3328
#define XB_TOPGEN   3392
#define XCD_BAR_WORDS 3456
#define XB_SPIN_CAP (1u << 18)

__device__ __forceinline__ unsigned xb_ld(unsigned* p)              { return __hip_atomic_load(p, __ATOMIC_RELAXED, __HIP_MEMORY_SCOPE_AGENT); }
__device__ __forceinline__ unsigned xb_add(unsigned* p, unsigned v) { return __hip_atomic_fetch_add(p, v, __ATOMIC_RELAXED, __HIP_MEMORY_SCOPE_AGENT); }
__device__ __forceinline__ unsigned xb_xcc_id() { return (unsigned)__builtin_amdgcn_s_getreg((3 << 11) | 20) & 0xFu; }
#define XB_SPIN(cond, bar) do { unsigned _sp = 0; while (cond) { __builtin_amdgcn_s_sleep(1); \
    if ((++_sp & 255u) == 0u) { if (xb_ld(&(bar)[XB_TMO])) break; if (_sp > XB_SPIN_CAP) { atomicAdd(&(bar)[XB_TMO], 1u); break; } } } } while (0)

struct XcdBarrier {
    unsigned* bar; unsigned x;
    volatile LAS unsigned* st;
};

__device__ __forceinline__ XcdBarrier xcd_barrier_post(unsigned* bar, volatile LAS unsigned* st) {
    XcdBarrier b; b.bar = bar; b.x = xb_xcc_id(); b.st = st;
    if (threadIdx.x == 0) (void)xb_add(&bar[XB_XCNT(b.x)], 1u);
    return b;
}
__device__ __forceinline__ void xcd_barrier_complete(unsigned* bar, unsigned x, unsigned& nloc, unsigned& nx) {
    const unsigned G = gridDim.x * gridDim.y * gridDim.z;
    unsigned sum, cnt, mine, sp = 0u;
    for (;;) {
        sum = 0u; cnt = 0u; mine = 0u;
#pragma unroll
        for (unsigned j = 0; j < 16; ++j) { const unsigned c = xb_ld(&bar[XB_XCNT(j)]); sum += c; cnt += (c > 0u) ? 1u : 0u; mine = (j == x) ? c : mine; }
        if (sum == G) break;
        __builtin_amdgcn_s_sleep(1);
        if ((++sp & 255u) == 0u) { if (xb_ld(&bar[XB_TMO])) break; if (sp > XB_SPIN_CAP) { atomicAdd(&bar[XB_TMO], 1u); break; } }
    }
    nloc = mine > 0u ? mine : 1u; nx = cnt > 0u ? cnt : 1u;
}

__device__ __forceinline__ void xcd_barrier(const XcdBarrier& b) {
    asm volatile("s_waitcnt vmcnt(0)" ::: "memory");
    __syncthreads();
    if (threadIdx.x == 0) {
        unsigned* bar = b.bar;
        __builtin_amdgcn_s_waitcnt(0);
        unsigned nloc = b.st[0], nx = b.st[1];
        if (nloc == 0u) { xcd_barrier_complete(bar, b.x, nloc, nx); b.st[0] = nloc; b.st[1] = nx; }
        const unsigned old = xb_add(&bar[XB_XSUB(b.x)], 1u);
        const unsigned gen = old / nloc;
        if (old + 1u == (gen + 1u) * nloc) {
            __builtin_amdgcn_fence(__ATOMIC_RELEASE, "agent");
            asm volatile("s_waitcnt vmcnt(0)" ::: "memory");
            const unsigned og = xb_add(&bar[XB_TOP], 1u);
            const unsigned tg = og / nx;
            if (og + 1u == (tg + 1u) * nx) xb_add(&bar[XB_TOPGEN], 1u);
            else XB_SPIN(xb_ld(&bar[XB_TOPGEN]) == tg, bar);
            __builtin_amdgcn_fence(__ATOMIC_ACQUIRE, "agent");
            xb_add(&bar[XB_XGEN(b.x)], 1u);
            asm volatile("s_waitcnt vmcnt(0)" ::: "memory");
        } else {
            XB_SPIN(xb_ld(&bar[XB_XGEN(b.x)]) == gen, bar);
            __builtin_amdgcn_fence(__ATOMIC_ACQUIRE, "agent");
            asm volatile("s_waitcnt vmcnt(0)" ::: "memory");
        }
    }
    __syncthreads();
}

__device__ unsigned g_ctl[4096 + XCD_BAR_WORDS];
constexpr int CTL_EXIT = 64;
struct Args { const void* in[20]; float* out; unsigned char* ws; };
#define CG_SYNC() do { asm volatile("s_waitcnt vmcnt(0) lgkmcnt(0)" ::: "memory"); __syncthreads(); grid.sync(); \
    if (threadIdx.x < 64) { __builtin_amdgcn_fence(__ATOMIC_ACQUIRE, "agent"); asm volatile("s_waitcnt vmcnt(0)" ::: "memory"); }     \
    __syncthreads(); } while (0)
#define GRID_SYNC() xcd_barrier(xbar)

__global__ void __launch_bounds__(NWAVES * 64, 2) fwd_megakernel(Args args) {
    extern __shared__ __attribute__((aligned(16))) unsigned char lds_raw[];
    cg::grid_group grid = cg::this_grid();
    LAS unsigned char* lds = (LAS unsigned char*)lds_raw;
    int tid = threadIdx.x, lane = tid & 63; const int wave = __builtin_amdgcn_readfirstlane(tid >> 6);
    const int G = gridDim.x, bx = blockIdx.x;
    const int vcu = (G % 8 == 0) ? (bx % 8) * (G / 8) + bx / 8 : bx;
    const int gw = vcu * NWAVES + wave, NGW = G * NWAVES;
    int gt = bx * (NWAVES * 64) + tid; const int NGT = G * NWAVES * 64;
    unsigned char* ws = args.ws;
    volatile LAS unsigned* MISC = (volatile LAS unsigned*)(lds + 131072);
    if (tid < 64) MISC[tid] = 0u;
    __syncthreads();
    XcdBarrier xbar = xcd_barrier_post(g_ctl + 4096, MISC + 8);
    const float* x = (const float*)args.in[0]; const float* pin = (const float*)args.in[1]; const int* positions = (const int*)args.in[2];
    const float* g_mix = (const float*)args.in[3]; const float* w_in = (const float*)args.in[4]; const float* g_q_a = (const float*)args.in[5]; const float* w_q_b = (const float*)args.in[6];
    const float* g_kv_a = (const float*)args.in[7]; const float* w_kv_b = (const float*)args.in[8]; const float* w_br_mla = (const float*)args.in[9]; const float* w_br_sb = (const float*)args.in[10];
    const float* w_out = (const float*)args.in[11]; const float* g_ffn = (const float*)args.in[12]; const float* w_ffn_gate = (const float*)args.in[13]; const float* w_ffn_up = (const float*)args.in[14];
    const float* w_ffn_down = (const float*)args.in[15]; const float* w_ple_gate = (const float*)args.in[16]; const float* w_ple_proj = (const float*)args.in[17]; const float* g_ple = (const float*)args.in[18];
    const float* g_final = (const float*)args.in[19];
    float* H = args.out;
    unsigned char* wsq = ws;
#define NEWPHASE() do { wsq = ws; asm volatile("" : "+s"(wsq)); tid = threadIdx.x; asm volatile("" : "+v"(tid)); lane = tid & 63; gt = bx * (NWAVES * 64) + tid; } while (0)
#define WIN ((bf16*)(wsq + (WS_WIN)))
#define WQB ((bf16*)(wsq + (WS_WQB)))
#define WKVB ((bf16*)(wsq + (WS_WKVB)))
#define WBRA ((bf16*)(wsq + (WS_WBRA)))
#define WBRB ((bf16*)(wsq + (WS_WBRB)))
#define WOUT ((bf16*)(wsq + (WS_WOUT)))
#define WGU ((bf16*)(wsq + (WS_WGU)))
#define WDN ((bf16*)(wsq + (WS_WDN)))
#define WPG ((bf16*)(wsq + (WS_WPG)))
#define WPP ((bf16*)(wsq + (WS_WPP)))
#define SSQ ((float*)(wsq + (37 * MiB)))
#define SSKV ((float*)(wsq + (46 * MiB)))
#define COS ((float*)(wsq + (WS_COS)))
#define SIN ((float*)(wsq + (WS_SIN)))
#define KPE ((bf16*)(wsq + (WS_KPE)))
#define PB ((bf16*)(wsq + (WS_PB)))
#define XN ((bf16*)(wsq + (WS_XN)))
#define CQN ((bf16*)(wsq + (WS_CQN)))
#define CKVN ((bf16*)(wsq + (WS_CKVN)))
#define OA ((bf16*)(wsq + (WS_OA)))
#define OB ((bf16*)(wsq + (WS_OB)))
#define PROJ ((bf16*)(wsq + (WS_PROJ)))
#define ACT ((bf16*)(wsq + (WS_ACT)))
#define EP ((bf16*)(wsq + (WS_EP)))
#define GS ((bf16*)(wsq + (WS_GS)))
#define H1B ((bf16*)(wsq + (WS_EP)))
#define Qb ((bf16*)(wsq + (WS_Q)))
#define KVb ((bf16*)(wsq + (WS_KV)))
#define MERGED ((bf16*)(wsq + (WS_MERGED)))
#define H2B ((bf16*)(wsq + (WS_H2B)))

    NEWPHASE();
    {
        LAS float* scr = (LAS float*)(lds + wave * 16384);
        constexpr int I_IN = 16 * 133, I_QB = 6 * 24, I_KVB = 4 * 32, I_BR = 8 * 32, I_OUT = 16 * 32, I_G = 16 * 88, I_DN = 44 * 32, I_PG = 16 * 32, I_PP = 4 * 32;
        constexpr int NITEMS = I_IN + I_QB + I_KVB + 2 * I_BR + I_OUT + 2 * I_G + I_DN + I_PG + I_PP;
        for (int it = gw; it < NITEMS; it += NGW) {
            int r = it;
            if (r < I_IN) { transpose_item(w_in, 1024, 4256, WIN, 1, scr, r, lane); continue; } r -= I_IN;
            if (r < I_QB) { transpose_item(w_q_b, 384, 768, WQB, 0, scr, r, lane, g_q_a); continue; } r -= I_QB;
            if (r < I_KVB) { transpose_item(w_kv_b, 256, 1024, WKVB, 0, scr, r, lane, g_kv_a); continue; } r -= I_KVB;
            if (r < I_BR) { transpose_item(w_br_mla, 512, 1024, WBRA, 0, scr, r, lane, nullptr, 1024, 0); continue; } r -= I_BR;
            if (r < I_BR) { transpose_item(w_br_sb, 512, 1024, WBRA, 0, scr, r, lane, nullptr, 1024, 512); continue; } r -= I_BR;
            if (r < I_OUT) { transpose_item(w_out, 1024, 1024, WOUT, 0, scr, r, lane); continue; } r -= I_OUT;
            if (r < I_G) { transpose_item(w_ffn_gate, 1024, 2816, WGU, 2, scr, r, lane); continue; } r -= I_G;
            if (r < I_G) { transpose_item(w_ffn_up, 1024, 2816, WGU, 3, scr, r, lane); continue; } r -= I_G;
            if (r < I_DN) { transpose_item(w_ffn_down, 2816, 1024, WDN, 0, scr, r, lane); continue; } r -= I_DN;
            if (r < I_PG) { transpose_item(w_ple_gate, 1024, 1024, WPG, 0, scr, r, lane); continue; } r -= I_PG;
            transpose_item(w_ple_proj, 256, 1024, WPP, 0, scr, r, lane);
        }
        for (int i = gt; i < 96 * 1024 / 8; i += NGT) *(v4u*)(WIN + (size_t)672 * 1024 + (size_t)i * 8) = (v4u){0u, 0u, 0u, 0u};
        for (int m = gw; m < NTOK; m += 4 * NGW) rms_rows_to_bf16<4>(x, g_mix, XN, m, NGW, lane);
        for (int i = gt; i < NTOK * PLE / 8; i += NGT) { const f32x4 a = __builtin_nontemporal_load((const f32x4*)(pin + (size_t)i * 8)), b = __builtin_nontemporal_load((const f32x4*)(pin + (size_t)i * 8 + 4));
            v4u o; o.x = pk2(a.x, a.y); o.y = pk2(a.z, a.w); o.z = pk2(b.x, b.y); o.w = pk2(b.z, b.w); *(v4u*)(PB + (size_t)i * 8) = o; }
        for (int i = gt; i < NTOK * 16; i += NGT) { const int m = i >> 4, j = i & 15; const float ang = (float)positions[m] * inv_freq(j);
            const double rev = (double)ang * 0.15915494309189535; const float fr = (float)(rev - __builtin_floor(rev));
            COS[i] = __builtin_amdgcn_cosf(fr); SIN[i] = __builtin_amdgcn_sinf(fr); }
    }
    if (__builtin_expect(args.ws == nullptr, 0)) CG_SYNC();
    GRID_SYNC();

    NEWPHASE();
    { pg8::Gemm g{XN, WIN, NTOK, DINP, DM}; pg8::StaticOrder S; S.init(NTOK, DINP, G, bx);
      pg8::Epi<pg8::M_PROJ> E{PROJ, DINP, nullptr, 0, nullptr, nullptr, 1.f, (float*)ws, 0, 0.f};
      pg8::gemm_phase<pg8::Epi<pg8::M_PROJ>, pg8::StaticOrder, true, true>(lds, g, S, E); }
    GRID_SYNC();


    NEWPHASE();
    { pg8::Gemm g{PROJ + C_CQ, WQB, NTOK, 768, QRANK, DINP}; pg8::StaticOrder S; S.init(NTOK, 768, G, bx);
      pg8::Epi<pg8::M_SCALER> E{Qb, 768, nullptr, 0, nullptr, nullptr, MLA_C2, SSQ, 12, 1.f / QRANK};
      pg8::gemm_phase<pg8::Epi<pg8::M_SCALER>, pg8::StaticOrder, true, true>(lds, g, S, E); }
    { pg8::Gemm g{PROJ + C_CKV, WKVB, NTOK, 1024, KVRANK, DINP}; pg8::StaticOrder S; S.init(NTOK, 1024, G, bx);
      pg8::Epi<pg8::M_SCALER> E{KVb, 1024, nullptr, 0, nullptr, nullptr, 1.f, SSKV, 8, 1.f / KVRANK};
      pg8::gemm_phase<pg8::Epi<pg8::M_SCALER>, pg8::StaticOrder, true, true>(lds, g, S, E); }
    GRID_SYNC();

    NEWPHASE();
    for (int i = 0;; ++i) { const int idx = i * G + vcu; if (idx >= 1024) break;
        const int rnd = idx >> 8, v = idx & 255, bh = v >> 2, s = v & 3; const int qb = (rnd == 0) ? 15 - s : (rnd == 1) ? 8 + s : (rnd == 2) ? 7 - s : s;
        att::mla_unit(bh >> 3, bh & 7, qb, Qb, KVb, KPE, COS, SIN, OA, (att::lptr)lds); }
    for (int i = 0;; ++i) { const int idx = i * G + vcu; if (idx >= 1024) break;
        const int rnd = idx >> 8, v = idx & 255, bh = v >> 2, s = v & 3; const int qb = (rnd == 0) ? 15 - s : (rnd == 1) ? 8 + s : (rnd == 2) ? 7 - s : s;
        att::sb_unit(bh >> 3, bh & 7, qb, PROJ, OA, (att::lptr)lds); }
    GRID_SYNC();

    NEWPHASE();
    { pg8::Gemm g{OA, WBRA, NTOK, 1024, 512, 1024, 1024}; pg8::SplitOrder S; S.base.init(NTOK, 1024, G, bx);
      pg8::Epi<pg8::M_GATEF> E{MERGED, 1024, PROJ + C_GA, DINP, nullptr, nullptr, 1.f, nullptr, 0, 0.f};
      pg8::gemm_phase<pg8::Epi<pg8::M_GATEF>, pg8::SplitOrder, true, true>(lds, g, S, E); }
    GRID_SYNC();

    NEWPHASE();
    { pg8::Gemm g{MERGED, WOUT, NTOK, 1024, 1024}; pg8::StaticOrder S; S.init(NTOK, 1024, G, bx);
      pg8::Epi<pg8::M_RES> E{H1B, 1024, nullptr, 0, x, nullptr, 1.f, nullptr, 0, 0.f};
      pg8::gemm_phase<pg8::Epi<pg8::M_RES>, pg8::StaticOrder, true, true>(lds, g, S, E); }
    GRID_SYNC();

    NEWPHASE();
    { int tid7 = threadIdx.x; asm volatile("" : "+v"(tid7)); const int lane7 = tid7 & 63;
      for (int m = gw; m < NTOK; m += 4 * NGW) rms_rows_bf16_to_bf16<4>(H1B, g_ffn, XN, m, NGW, lane7); }
    GRID_SYNC();

    NEWPHASE();
    { pg8::Gemm g{XN, WGU, NTOK, 2 * DFF, DM}; pg8::StaticOrder S; S.init(NTOK, 2 * DFF, G, bx);
      pg8::Epi<pg8::M_SWIGLU> E{ACT, DFF, nullptr, 0, nullptr, nullptr, 1.f, nullptr, 0, 0.f};
      pg8::gemm_phase<pg8::Epi<pg8::M_SWIGLU>, pg8::StaticOrder, true, true>(lds, g, S, E); }
    GRID_SYNC();

    NEWPHASE();
    { pg8::Gemm g{ACT, WDN, NTOK, 1024, DFF}; pg8::StaticOrder S; S.init(NTOK, 1024, G, bx);
      pg8::Epi<pg8::M_RES2> E{H2B, 1024, H1B, 1024, nullptr, nullptr, 1.f, nullptr, 0, 0.f};
      pg8::gemm_phase<pg8::Epi<pg8::M_RES2>, pg8::StaticOrder, true, true>(lds, g, S, E); }
    GRID_SYNC();

    NEWPHASE();
    { pg8::Gemm g{PB, WPP, NTOK, 1024, PLE}; pg8::StaticOrder S; S.init(NTOK, 1024, G, bx);
      pg8::Epi<pg8::M_SCALE> E{EP, 1024, nullptr, 0, nullptr, nullptr, 1.f, nullptr, 0, 0.f};
      pg8::gemm_phase<pg8::Epi<pg8::M_SCALE>, pg8::StaticOrder, false, true>(lds, g, S, E); }
    { pg8::Gemm g{H2B, WPG, NTOK, 1024, 1024}; pg8::StaticOrder S; S.init(NTOK, 1024, G, bx);
      pg8::Epi<pg8::M_SIG> E{GS, 1024, nullptr, 0, nullptr, nullptr, 1.f, nullptr, 0, 0.f};
      pg8::gemm_phase<pg8::Epi<pg8::M_SIG>, pg8::StaticOrder, true, true>(lds, g, S, E); }
    GRID_SYNC();

    NEWPHASE();
    int tid11 = threadIdx.x; asm volatile("" : "+v"(tid11)); const int lane11 = tid11 & 63;
    for (int m0 = gw; m0 < NTOK; m0 += 2 * NGW) {
        f32x4 v[2][4], e[2][4], gsv[2][4]; float se[2], s3[2];
#pragma unroll
        for (int r = 0; r < 2; ++r) { const size_t m = (size_t)(m0 + r * NGW);
            const v2u* hr = (const v2u*)(H2B + m * DM) + lane11; const v2u* er = (const v2u*)(EP + m * DM) + lane11; const v2u* sr = (const v2u*)(GS + m * DM) + lane11;
#pragma unroll
            for (int j = 0; j < 4; ++j) { const v2u wh = __builtin_nontemporal_load(hr + 64 * j); v[r][j] = (f32x4){pg8::bf_lo(wh.x), pg8::bf_hi(wh.x), pg8::bf_lo(wh.y), pg8::bf_hi(wh.y)}; const v2u w = __builtin_nontemporal_load(er + 64 * j); const v2u w2 = __builtin_nontemporal_load(sr + 64 * j);
                e[r][j] = (f32x4){pg8::bf_lo(w.x), pg8::bf_hi(w.x), pg8::bf_lo(w.y), pg8::bf_hi(w.y)}; gsv[r][j] = (f32x4){pg8::bf_lo(w2.x), pg8::bf_hi(w2.x), pg8::bf_lo(w2.y), pg8::bf_hi(w2.y)}; } }
        f32x4 gp4[4], gf4[4];
#pragma unroll
        for (int j = 0; j < 4; ++j) { gp4[j] = ((const f32x4*)g_ple + lane11)[64 * j]; gf4[j] = ((const f32x4*)g_final + lane11)[64 * j]; }
#pragma unroll
        for (int r = 0; r < 2; ++r) { se[r] = 0.f;
#pragma unroll
            for (int j = 0; j < 4; ++j) se[r] += (e[r][j].x * e[r][j].x + e[r][j].y * e[r][j].y) + (e[r][j].z * e[r][j].z + e[r][j].w * e[r][j].w); }
#pragma unroll
        for (int o = 1; o < 64; o <<= 1) { se[0] += __shfl_xor(se[0], o); se[1] += __shfl_xor(se[1], o); }
#pragma unroll
        for (int r = 0; r < 2; ++r) { const float rse = 1.0f / sqrtf(se[r] * (1.f / DM) + EPS); s3[r] = 0.f;
#pragma unroll
            for (int j = 0; j < 4; ++j) { v[r][j] = v[r][j] + gsv[r][j] * (e[r][j] * rse * gp4[j]); s3[r] += (v[r][j].x * v[r][j].x + v[r][j].y * v[r][j].y) + (v[r][j].z * v[r][j].z + v[r][j].w * v[r][j].w); } }
#pragma unroll
        for (int o = 1; o < 64; o <<= 1) { s3[0] += __shfl_xor(s3[0], o); s3[1] += __shfl_xor(s3[1], o); }
#pragma unroll
        for (int r = 0; r < 2; ++r) { const float rs3 = 1.0f / sqrtf(s3[r] * (1.f / DM) + EPS); f32x4* hw = (f32x4*)(H + (size_t)(m0 + r * NGW) * DM) + lane11;
#pragma unroll
            for (int j = 0; j < 4; ++j) __builtin_nontemporal_store(v[r][j] * rs3 * gf4[j], hw + 64 * j); }
    }
    __syncthreads();
    if (threadIdx.x == 0) { const unsigned old = __hip_atomic_fetch_add(&g_ctl[CTL_EXIT], 1u, __ATOMIC_ACQ_REL, __HIP_MEMORY_SCOPE_AGENT); MISC[16] = (old == (unsigned)G - 1u) ? 1u : 0u; }
    __syncthreads();
    if (MISC[16] != 0u) {
        for (int i = threadIdx.x; i < XCD_BAR_WORDS; i += NWAVES * 64) __hip_atomic_store(&g_ctl[4096 + i], 0u, __ATOMIC_RELAXED, __HIP_MEMORY_SCOPE_AGENT);
        if (threadIdx.x == 0) __hip_atomic_store(&g_ctl[CTL_EXIT], 0u, __ATOMIC_RELAXED, __HIP_MEMORY_SCOPE_AGENT);
        __builtin_amdgcn_fence(__ATOMIC_RELEASE, "agent");
    }
}

#undef WIN
#undef WQB
#undef WKVB
#undef WBRA
#undef WBRB
#undef WOUT
#undef WGU
#undef WDN
#undef WPG
#undef WPP
#undef SSQ
#undef SSKV
#undef COS
#undef SIN
#undef KPE
#undef PB
#undef XN
#undef CQN
#undef CKVN
#undef OA
#undef OB
#undef PROJ
#undef ACT
#undef EP
#undef GS
#undef H1B
#undef Qb
#undef KVb
#undef MERGED
#undef H2B
#undef NEWPHASE
extern "C" void kernel_launch(void* const* d_in, const int* in_sizes, int n_in, void* d_out, int out_size, void* d_ws, size_t ws_size, hipStream_t stream) {
    static int grid = 0;
    if (grid == 0) {
        if (n_in != 20 || out_size != NTOK * DM || ws_size < WS_END) { fprintf(stderr, "kernel_launch: unexpected shapes (n_in %d out %d ws %zu)\n", n_in, out_size, ws_size); grid = -1; return; }
        int dev = 0, cus = 0, per_cu = 0;
        if (hipGetDevice(&dev) != hipSuccess || hipDeviceGetAttribute(&cus, hipDeviceAttributeMultiprocessorCount, dev) != hipSuccess) { grid = -1; return; }
        if (hipFuncSetAttribute((const void*)fwd_megakernel, hipFuncAttributeMaxDynamicSharedMemorySize, LDS_BYTES) != hipSuccess) { fprintf(stderr, "kernel_launch: hipFuncSetAttribute failed\n"); grid = -1; return; }
        if (hipOccupancyMaxActiveBlocksPerMultiprocessor(&per_cu, (const void*)fwd_megakernel, NWAVES * 64, LDS_BYTES) != hipSuccess || per_cu < 1) { fprintf(stderr, "kernel_launch: occupancy query says %d\n", per_cu); per_cu = 1; }
        (void)hipGetLastError();
        grid = cus;
    }
    if (grid < 0) return;
    Args a{};
    for (int i = 0; i < 20; ++i) a.in[i] = d_in[i];
    a.out = (float*)d_out; a.ws = (unsigned char*)d_ws;
    void* kargs[] = {&a};
    hipError_t e = hipLaunchCooperativeKernel((const void*)fwd_megakernel, dim3(grid), dim3(NWAVES * 64), kargs, LDS_BYTES, stream);
    if (e != hipSuccess) fprintf(stderr, "kernel_launch: cooperative launch failed: %s (grid %d)\n", hipGetErrorString(e), grid);
}
```
